# Optimizing an MI355X kernel written in HIP

```python
import math
import jax, jax.numpy as jnp
from jax import lax
import numpy as np


D_MODEL = 1024
BATCH = 16
SEQ = 2048
DEPTH = 4

N_MIXERS = 3
Q_BLK = 128
NORM_EPS = 1e-5
RMS_EPS = 1e-6

REL_BUCKETS = 32
REL_MAX_DIST = 2048
REL_HEADS = 16

A_HEADS = 16
A_HEAD_DIM = 128
A_IDX_HEADS = 8
A_IDX_DIM = 64
A_TOPK_MAX = 256
A_Q = A_HEADS * A_HEAD_DIM
A_SPLITS = (A_Q, A_Q + A_HEAD_DIM, A_Q + 2 * A_HEAD_DIM,
            A_Q + 2 * A_HEAD_DIM + A_IDX_HEADS * A_IDX_DIM,
            A_Q + 2 * A_HEAD_DIM + A_IDX_HEADS * A_IDX_DIM + A_IDX_DIM)
A_IN = A_SPLITS[-1] + A_IDX_HEADS

B_GROUPS = ((128, 1), (512, 4), (2048, 16))
B_HEADS = 16
B_HEAD_DIM = 64
B_IN = len(B_GROUPS) * 3 * B_HEADS * B_HEAD_DIM

C_HEADS = 16
C_Q_RANK = 256
C_KV_RANK = 128
C_NOPE = 64
C_ROPE = 32
C_V = 64
C_IN = C_Q_RANK + C_KV_RANK + C_ROPE
ROPE_BASE = 10000.0

N_EXPERTS = 64
TOP_K = 8
N_GROUPS = 8
TOPK_GROUPS = 4
D_EXPERT = 256
D_SHARED = 256
ROUTED_SCALE = 2.5
MOE_BLK = 256

DN_ALPHA = (2 * DEPTH) ** 0.25
DN_BETA = (8 * DEPTH) ** -0.25
N_A = len(range(0, DEPTH, N_MIXERS))
N_B = len(range(1, DEPTH, N_MIXERS))
N_C = len(range(2, DEPTH, N_MIXERS))

kernel_name = 'hybrid_dsa_dilated_mla_moe_deepnorm'


def layer_norm(x, g, b):
    xf = x.astype(jnp.float32)
    mu = jnp.mean(xf, axis=-1, keepdims=True)
    var = jnp.mean(jnp.square(xf - mu), axis=-1, keepdims=True)
    return ((xf - mu) * lax.rsqrt(var + NORM_EPS) * g.astype(jnp.float32) + b.astype(jnp.float32)).astype(x.dtype)


def rms_norm(x, g):
    xf = x.astype(jnp.float32)
    y = xf * lax.rsqrt(jnp.mean(jnp.square(xf), axis=-1, keepdims=True) + RMS_EPS)
    return (y * g.astype(jnp.float32)).astype(x.dtype)


def rope(x, pos):
    half = x.shape[-1] // 2
    inv = ROPE_BASE ** (-jnp.arange(half, dtype=jnp.float32) / half)
    ang = pos.astype(jnp.float32)[:, None] * inv[None, :]
    cos, sin = jnp.cos(ang)[:, None, :], jnp.sin(ang)[:, None, :]
    xf = x.astype(jnp.float32)
    x1, x2 = xf[..., :half], xf[..., half:]
    return jnp.concatenate([x1 * cos - x2 * sin, x1 * sin + x2 * cos], axis=-1).astype(x.dtype)


def t5_bucket(dist):
    exact = REL_BUCKETS // 2
    d_f = jnp.maximum(dist, 1).astype(jnp.float32)
    large = exact + (jnp.log(d_f / exact) / math.log(REL_MAX_DIST / exact) * (REL_BUCKETS - exact)).astype(jnp.int32)
    return jnp.where(dist < exact, dist, jnp.minimum(large, REL_BUCKETS - 1))


def t5_bias(rel_bias, dist):
    return rel_bias[t5_bucket(dist)]


def to_blocks(a):
    b, s = a.shape[0], a.shape[1]
    return jnp.swapaxes(a.reshape(b, s // Q_BLK, Q_BLK, *a.shape[2:]), 0, 1)


def from_blocks(a):
    a = jnp.swapaxes(a, 0, 1)
    return a.reshape(a.shape[0], a.shape[1] * a.shape[2], *a.shape[3:])


def dsa_mixer(x, w_in, w_o, rel_bias):
    bsz, seq, _ = x.shape
    k_sel = min(A_TOPK_MAX, seq // 4)
    q, k, v, qi, ki, wi = jnp.split(x @ w_in, list(A_SPLITS), axis=-1)
    q = q.reshape(bsz, seq, A_HEADS, A_HEAD_DIM)
    qi = qi.reshape(bsz, seq, A_IDX_HEADS, A_IDX_DIM)
    ki = ki.astype(jnp.float32)
    pos = jnp.arange(seq)
    gather = jax.vmap(lambda a, i: a[i])

    def block(args):
        start, q_b, qi_b, wi_b = args
        t = start + jnp.arange(Q_BLK)
        rel = jax.nn.relu(jnp.einsum('bthe,bse->bhts', qi_b.astype(jnp.float32), ki) * A_IDX_DIM ** -0.5)
        score = jnp.einsum('bth,bhts->bts', wi_b.astype(jnp.float32) * A_IDX_HEADS ** -0.5, rel)
        score = jnp.where(pos[None, :] <= t[:, None], score, -jnp.inf)
        _, idx = lax.top_k(score, k_sel)
        k_g, v_g = gather(k, idx), gather(v, idx)
        logits = jnp.einsum('bthe,btke->bhtk', q_b, k_g).astype(jnp.float32) * A_HEAD_DIM ** -0.5
        dist = t[None, :, None] - idx
        logits = logits + jnp.moveaxis(t5_bias(rel_bias, jnp.maximum(dist, 0)), -1, 1).astype(jnp.float32)
        logits = jnp.where((dist >= 0)[:, None], logits, -jnp.inf)
        p = jax.nn.softmax(logits, axis=-1).astype(v.dtype)
        return jnp.einsum('bhtk,btke->bthe', p, v_g)

    starts = jnp.arange(seq // Q_BLK) * Q_BLK
    o = lax.map(block, (starts, to_blocks(q), to_blocks(qi), to_blocks(wi)))
    return from_blocks(o).reshape(bsz, seq, A_Q) @ w_o


def dilated_group(q, k, v, rel_bias, window, dil):
    bsz, seq, nh, hd = q.shape
    n = window // dil
    span = n * dil
    sp = -(-seq // span) * span
    nb = sp // span

    def split(a):
        a = jnp.pad(a, ((0, 0), (0, sp - seq), (0, 0), (0, 0)))
        return a.reshape(bsz, nb, n, dil, nh, hd)

    def with_prev(a):
        prev = jnp.pad(a, ((0, 0), (1, 0), (0, 0), (0, 0), (0, 0), (0, 0)))[:, :-1]
        return jnp.concatenate([prev, a], axis=2)

    qs = split(q)
    kk, vv = with_prev(split(k)), with_prev(split(v))
    logits = jnp.einsum('bcirhe,bcjrhe->bcrhij', qs, kk).astype(jnp.float32) * hd ** -0.5
    ii = jnp.arange(n)[:, None]
    jj = jnp.arange(2 * n)[None, :]
    delta = n + ii - jj
    band = (delta >= 0) & (delta <= n)
    exists = (jnp.arange(nb)[:, None, None] > 0) | (jj[None] >= n)
    mask = band[None] & exists
    bias = jnp.transpose(t5_bias(rel_bias, jnp.maximum(delta, 0) * dil), (2, 0, 1))
    logits = logits + bias.astype(jnp.float32)
    logits = jnp.where(mask[None, :, None, None], logits, -jnp.inf)
    lse = jax.nn.logsumexp(logits, axis=-1)
    p = jnp.exp(logits - lse[..., None]).astype(v.dtype)
    o = jnp.einsum('bcrhij,bcjrhe->bcirhe', p, vv).reshape(bsz, sp, nh, hd)[:, :seq]
    lse = jnp.transpose(lse, (0, 1, 4, 2, 3)).reshape(bsz, sp, nh)[:, :seq]
    return o, lse


def dilated_mixer(x, w_in, w_o, rel_bias):
    bsz, seq, _ = x.shape
    proj = (x @ w_in).reshape(bsz, seq, len(B_GROUPS), 3, B_HEADS, B_HEAD_DIM)
    outs, lses = [], []
    for g, (window, dil) in enumerate(B_GROUPS):
        o, l = dilated_group(proj[:, :, g, 0], proj[:, :, g, 1], proj[:, :, g, 2], rel_bias, window, dil)
        outs.append(o)
        lses.append(l)
    wts = jax.nn.softmax(jnp.stack(lses, axis=2), axis=2)
    o = jnp.einsum('bsgh,bsghe->bshe', wts.astype(x.dtype), jnp.stack(outs, axis=2))
    return o.reshape(bsz, seq, B_HEADS * B_HEAD_DIM) @ w_o


def mla_mixer(x, w_in, q_norm, kv_norm, w_q_up, w_kv_up, w_o):
    bsz, seq, _ = x.shape
    c_q, c_kv, k_r = jnp.split(x @ w_in, [C_Q_RANK, C_Q_RANK + C_KV_RANK], axis=-1)
    q = (rms_norm(c_q, q_norm) @ w_q_up).reshape(bsz, seq, C_HEADS, C_NOPE + C_ROPE)
    kv = (rms_norm(c_kv, kv_norm) @ w_kv_up).reshape(bsz, seq, C_HEADS, C_NOPE + C_V)
    pos = jnp.arange(seq)
    q_nope, q_rope = q[..., :C_NOPE], rope(q[..., C_NOPE:], pos)
    k_rope = rope(k_r[:, :, None, :], pos)[:, :, 0]
    k_nope, v = kv[..., :C_NOPE], kv[..., C_NOPE:]
    scale = (C_NOPE + C_ROPE) ** -0.5

    def block(args):
        start, qn_b, qr_b = args
        t = start + jnp.arange(Q_BLK)
        logits = (jnp.einsum('bthe,bshe->bhts', qn_b, k_nope)
                  + jnp.einsum('bthe,bse->bhts', qr_b, k_rope)).astype(jnp.float32) * scale
        logits = jnp.where(pos[None, :] <= t[:, None], logits, -jnp.inf)
        p = jax.nn.softmax(logits, axis=-1).astype(v.dtype)
        return jnp.einsum('bhts,bshe->bthe', p, v)

    starts = jnp.arange(seq // Q_BLK) * Q_BLK
    o = lax.map(block, (starts, to_blocks(q_nope), to_blocks(q_rope)))
    return from_blocks(o).reshape(bsz, seq, C_HEADS * C_V) @ w_o


def swiglu(x, w_gate, w_up, w_down):
    return (jax.nn.silu(x @ w_gate) * (x @ w_up)) @ w_down


def grouped_experts(tok, eidx, gate, w_gate, w_up, w_down):
    n_tok, d = tok.shape
    n_asg = n_tok * TOP_K
    flat_e = eidx.reshape(-1)
    order = jnp.argsort(flat_e)
    sorted_e = flat_e[order]
    counts = jnp.bincount(flat_e, length=N_EXPERTS)
    padded = (counts + MOE_BLK - 1) // MOE_BLK * MOE_BLK
    pad_end = jnp.cumsum(padded)
    pad_start = pad_end - padded
    start = jnp.cumsum(counts) - counts
    dest = pad_start[sorted_e] + jnp.arange(n_asg) - start[sorted_e]
    n_blk = -(-n_asg // MOE_BLK) + N_EXPERTS
    n_slot = n_blk * MOE_BLK
    slot_tok = jnp.full((n_slot,), n_tok, jnp.int32).at[dest].set((order // TOP_K).astype(jnp.int32))
    slot_w = jnp.zeros((n_slot,), gate.dtype).at[dest].set(gate.reshape(-1)[order])
    blk_e = jnp.minimum(jnp.searchsorted(pad_end, jnp.arange(n_blk) * MOE_BLK, side='right'), N_EXPERTS - 1)
    tok_pad = jnp.concatenate([tok, jnp.zeros((1, d), tok.dtype)], axis=0)

    def block(args):
        e, rows, wts = args
        xb = tok_pad[rows]
        return swiglu(xb, w_gate[e], w_up[e], w_down[e]) * wts[:, None].astype(xb.dtype)

    out = lax.map(block, (blk_e, slot_tok.reshape(n_blk, MOE_BLK), slot_w.reshape(n_blk, MOE_BLK)))
    return jax.ops.segment_sum(out.reshape(n_slot, d), slot_tok, num_segments=n_tok + 1)[:n_tok]


def moe(h, w_router, e_bias, w_gate, w_up, w_down, ws_gate, ws_up, ws_down):
    bsz, seq, d = h.shape
    tok = h.reshape(-1, d)
    n_tok = tok.shape[0]
    scores = jax.nn.sigmoid((tok @ w_router).astype(jnp.float32))
    choice = scores + e_bias.astype(jnp.float32)
    grp_score = lax.top_k(choice.reshape(n_tok, N_GROUPS, N_EXPERTS // N_GROUPS), 2)[0].sum(-1)
    _, gi = lax.top_k(grp_score, TOPK_GROUPS)
    gmask = jnp.sum(jax.nn.one_hot(gi, N_GROUPS, dtype=jnp.float32), axis=1) > 0
    choice = jnp.where(jnp.repeat(gmask, N_EXPERTS // N_GROUPS, axis=1), choice, -jnp.inf)
    _, eidx = lax.top_k(choice, TOP_K)
    gate = jnp.take_along_axis(scores, eidx, axis=-1)
    gate = gate / jnp.sum(gate, axis=-1, keepdims=True) * ROUTED_SCALE
    routed = grouped_experts(tok, eidx, gate, w_gate, w_up, w_down)
    return (routed + swiglu(tok, ws_gate, ws_up, ws_down)).reshape(bsz, seq, d)


def setup_inputs(seed: int = 0) -> dict:
    key = jax.random.key(seed)
    keys = iter(jax.random.split(key, 32))

    def nrm(shape, fan_in, scale=1.0):
        return jax.random.normal(next(keys), shape, jnp.float32) * (scale * fan_in ** -0.5)

    def gain(shape):
        return 1.0 + 0.02 * jax.random.normal(next(keys), shape, jnp.float32)

    d = D_MODEL
    return {
        'x': jax.random.normal(next(keys), (BATCH, SEQ, d), jnp.float32),
        'rel_bias': 0.2 * jax.random.normal(next(keys), (REL_BUCKETS, REL_HEADS), jnp.float32),
        'a_w_in': nrm((N_A, d, A_IN), d),
        'a_w_o': nrm((N_A, A_Q, d), A_Q, DN_BETA),
        'b_w_in': nrm((N_B, d, B_IN), d),
        'b_w_o': nrm((N_B, B_HEADS * B_HEAD_DIM, d), B_HEADS * B_HEAD_DIM, DN_BETA),
        'c_w_in': nrm((N_C, d, C_IN), d),
        'c_q_norm': gain((N_C, C_Q_RANK)),
        'c_kv_norm': gain((N_C, C_KV_RANK)),
        'c_w_q_up': nrm((N_C, C_Q_RANK, C_HEADS * (C_NOPE + C_ROPE)), C_Q_RANK),
        'c_w_kv_up': nrm((N_C, C_KV_RANK, C_HEADS * (C_NOPE + C_V)), C_KV_RANK),
        'c_w_o': nrm((N_C, C_HEADS * C_V, d), C_HEADS * C_V, DN_BETA),
        'ln_g': gain((DEPTH, 2, d)),
        'ln_b': 0.02 * jax.random.normal(next(keys), (DEPTH, 2, d), jnp.float32),
        'moe_w_router': nrm((DEPTH, d, N_EXPERTS), d),
        'moe_bias': 0.01 * jax.random.normal(next(keys), (DEPTH, N_EXPERTS), jnp.float32),
        'moe_w_gate': nrm((DEPTH, N_EXPERTS, d, D_EXPERT), d),
        'moe_w_up': nrm((DEPTH, N_EXPERTS, d, D_EXPERT), d),
        'moe_w_down': nrm((DEPTH, N_EXPERTS, D_EXPERT, d), D_EXPERT, DN_BETA),
        'moe_ws_gate': nrm((DEPTH, d, D_SHARED), d),
        'moe_ws_up': nrm((DEPTH, d, D_SHARED), d),
        'moe_ws_down': nrm((DEPTH, D_SHARED, d), D_SHARED, DN_BETA),
    }


def reference(x, rel_bias, a_w_in, a_w_o, b_w_in, b_w_o, c_w_in, c_q_norm, c_kv_norm,
              c_w_q_up, c_w_kv_up, c_w_o, ln_g, ln_b, moe_w_router, moe_bias, moe_w_gate,
              moe_w_up, moe_w_down, moe_ws_gate, moe_ws_up, moe_ws_down):
    h = x
    for layer in range(DEPTH):
        kind, slot = layer % N_MIXERS, layer // N_MIXERS
        if kind == 0:
            mix = dsa_mixer(h, a_w_in[slot], a_w_o[slot], rel_bias)
        elif kind == 1:
            mix = dilated_mixer(h, b_w_in[slot], b_w_o[slot], rel_bias)
        else:
            mix = mla_mixer(h, c_w_in[slot], c_q_norm[slot], c_kv_norm[slot],
                            c_w_q_up[slot], c_w_kv_up[slot], c_w_o[slot])
        h = layer_norm(DN_ALPHA * h + mix, ln_g[layer, 0], ln_b[layer, 0])
        ff = moe(h, moe_w_router[layer], moe_bias[layer], moe_w_gate[layer], moe_w_up[layer],
                 moe_w_down[layer], moe_ws_gate[layer], moe_ws_up[layer], moe_ws_down[layer])
        h = layer_norm(DN_ALPHA * h + ff, ln_g[layer, 1], ln_b[layer, 1])
    return h
```

```cpp
#include <hip/hip_runtime.h>
#include <cstdio>
#include <cstdint>

#ifndef DEBUG_CHECKS
#define DEBUG_CHECKS 0
#endif
#ifndef MULTI_LAUNCH
#define MULTI_LAUNCH 0
#endif

#define LAS __attribute__((address_space(3)))
typedef unsigned short bf16_t;
typedef short bf16x8 __attribute__((ext_vector_type(8)));
typedef short s16x4 __attribute__((ext_vector_type(4)));
typedef float f32x2 __attribute__((ext_vector_type(2)));
typedef float f32x4 __attribute__((ext_vector_type(4)));
typedef float f32x16 __attribute__((ext_vector_type(16)));
typedef unsigned u32x4 __attribute__((ext_vector_type(4)));
typedef unsigned u32x2 __attribute__((ext_vector_type(2)));

constexpr int T = 32768, DM = 1024, SEQ = 2048, NBATCH = 16, DEPTH = 4;
constexpr float DN_ALPHA = 1.6817928305074292f;
constexpr float LOG2E = 1.4426950408889634f;
constexpr float LN2F = 0.6931471805599453f;
constexpr float NEGF = -1.0e30f;
constexpr int NSLOT_R = 8 * T + 64 * 256, SH_SLOT0 = NSLOT_R, NSLOT = NSLOT_R + T;
constexpr int GRID = 256, NTHREADS = 512, NWAVES_TOTAL = GRID * 8;

constexpr size_t WS_CTL = 0;
constexpr size_t CTL_DIAG = 16384, CTL_ETOT = 32768, CTL_BYTES = 65536;
constexpr size_t WS_TABA = 65536;
constexpr size_t WS_TABB = WS_TABA + 131072;
constexpr size_t WS_HB = 262144;
constexpr size_t WS_WB = WS_HB + (size_t)T * DM * 2;
constexpr size_t WB_GU = 0, WB_D = 68157440, WB_R = 102236160, WB_MIX = 102760448, WB_MIX2 = WB_MIX + 18874368, WB_BYTES = 125829120;
constexpr size_t WS_BIG = WS_WB + WB_BYTES;
constexpr size_t BIG_Y32 = 408944640;
constexpr size_t A_P = 0, A_BM = 201326592, A_O = 209715200, A_SC = 209715200;
constexpr size_t B_P = 0, B_O = 0, B_OG = 201326592, B_LSE = 402653184;
constexpr size_t C_P = 0, C_AQ = 33554432, C_AKV = 50331648, C_QF = 67108864, C_KF = 167772160, C_V = 268435456, C_O = 335544320;
constexpr size_t M_LOG = 0, M_AE = 8388608, M_AG = 9437184, M_APOS = 10485760, M_ASLOT = 11534336, M_WHIST = 12582912, M_STOK = 13107200, M_SW = 14352384, M_H = 16777216, M_YS = 176160768;
constexpr size_t BIG_BYTES = M_YS + (size_t)NSLOT * 1024 * 2;
constexpr size_t WS_END = WS_BIG + BIG_BYTES;

constexpr int LDS_STAGE = 0, LDS_BARW = 131072, LDS_BLK = 131072 + 64, LDS_NBLK = 131072 + 64 + 1280, LDS_BYTES = 135168;

__device__ __forceinline__ bf16_t f2bf(float f) { unsigned u = __float_as_uint(f); u += 0x7FFFu + ((u >> 16) & 1u); return (bf16_t)(u >> 16); }
__device__ __forceinline__ float bf2f(bf16_t b) { return __uint_as_float(((unsigned)b) << 16); }
__device__ __forceinline__ float bflo(unsigned w) { return __uint_as_float(w << 16); }
__device__ __forceinline__ float bfhi(unsigned w) { return __uint_as_float(w & 0xffff0000u); }
__device__ __forceinline__ unsigned cvt_pk_bf16(float lo, float hi) { unsigned r; asm volatile("v_cvt_pk_bf16_f32 %0, %1, %2" : "=v"(r) : "v"(lo), "v"(hi)); return r; }
__device__ __forceinline__ float swapmax(float v) { auto rr = __builtin_amdgcn_permlane32_swap(__float_as_uint(v), __float_as_uint(v), false, false); return fmaxf(__uint_as_float(rr[0]), __uint_as_float(rr[1])); }
__device__ __forceinline__ float swapadd2(float a, float b) { auto rr = __builtin_amdgcn_permlane32_swap(__float_as_uint(a), __float_as_uint(b), false, false); return __uint_as_float(rr[0]) + __uint_as_float(rr[1]); }
__device__ __forceinline__ int crow(int r, int hi) { return (r & 3) + 8 * (r >> 2) + 4 * hi; }

#define XB_TMO      128
#define XB_XCNT(j)  (256  + 64 * (j))
#define XB_XSUB(j)  (1280 + 64 * (j))
#define XB_XGEN(j)  (2304 + 64 * (j))
#define XB_TOP      3328
#define XB_TOPGEN   3392
#define XCD_BAR_WORDS 3456
#define XB_SPIN_CAP (1u << 18)
__device__ __forceinline__ unsigned xb_ld(unsigned* p)              { return __hip_atomic_load(p, __ATOMIC_RELAXED, __HIP_MEMORY_SCOPE_AGENT); }
__device__ __forceinline__ unsigned xb_add(unsigned* p, unsigned v) { return __hip_atomic_fetch_add(p, v, __ATOMIC_RELAXED, __HIP_MEMORY_SCOPE_AGENT); }
__device__ __forceinline__ unsigned xb_xcc_id() { return (unsigned)__builtin_amdgcn_s_getreg((3 << 11) | 20) & 0xFu; }
#define XB_SPIN(cond, bar) do { unsigned _sp = 0; while (cond) { __builtin_amdgcn_s_sleep(1); \
    if ((++_sp & 255u) == 0u) { if (xb_ld(&(bar)[XB_TMO])) break; if (_sp > XB_SPIN_CAP) { atomicAdd(&(bar)[XB_TMO], 1u); break; } } } } while (0)
struct XcdBarrier { unsigned* bar; unsigned x; volatile LAS unsigned* st; int wid; };
__device__ __forceinline__ int lane_id() { return (int)__builtin_amdgcn_mbcnt_hi(~0u, __builtin_amdgcn_mbcnt_lo(~0u, 0u)); }
__device__ __forceinline__ XcdBarrier xcd_barrier_post(unsigned* bar, volatile LAS unsigned* st, int wid) {
    XcdBarrier b; b.bar = bar; b.x = xb_xcc_id(); b.st = st; b.wid = wid;
    if (wid == 0 && lane_id() == 0) (void)xb_add(&bar[XB_XCNT(b.x)], 1u);
    return b;
}
__device__ __forceinline__ void xcd_barrier_complete(unsigned* bar, unsigned x, unsigned& nloc, unsigned& nx) {
    const unsigned G = gridDim.x * gridDim.y * gridDim.z;
    unsigned sum, cnt, mine, sp = 0u;
    for (;;) {
        sum = 0u; cnt = 0u; mine = 0u;
#pragma unroll
        for (unsigned j = 0; j < 16; ++j) { const unsigned c = xb_ld(&bar[XB_XCNT(j)]); sum += c; cnt += (c > 0u) ? 1u : 0u; mine = (j == x) ? c : mine; }
        if (sum == G) break;
        __builtin_amdgcn_s_sleep(1);
        if ((++sp & 255u) == 0u) { if (xb_ld(&bar[XB_TMO])) break; if (sp > XB_SPIN_CAP) { atomicAdd(&bar[XB_TMO], 1u); break; } }
    }
    nloc = mine > 0u ? mine : 1u; nx = cnt > 0u ? cnt : 1u;
}
__device__ __forceinline__ void xcd_barrier(const XcdBarrier& b) {
    asm volatile("s_waitcnt vmcnt(0)" ::: "memory");
    __syncthreads();
    if (b.wid == 0 && lane_id() == 0) {
        unsigned* bar = b.bar;
        __builtin_amdgcn_s_waitcnt(0);
        unsigned nloc = b.st[0], nx = b.st[1];
        if (nloc == 0u) { xcd_barrier_complete(bar, b.x, nloc, nx); b.st[0] = nloc; b.st[1] = nx; }
        const unsigned old = xb_add(&bar[XB_XSUB(b.x)], 1u);
        const unsigned gen = old / nloc;
        if (old + 1u == (gen + 1u) * nloc) {
            __builtin_amdgcn_fence(__ATOMIC_RELEASE, "agent");
            asm volatile("s_waitcnt vmcnt(0)" ::: "memory");
            const unsigned og = xb_add(&bar[XB_TOP], 1u);
            const unsigned tg = og / nx;
            if (og + 1u == (tg + 1u) * nx) xb_add(&bar[XB_TOPGEN], 1u);
            else XB_SPIN(xb_ld(&bar[XB_TOPGEN]) == tg, bar);
            __builtin_amdgcn_fence(__ATOMIC_ACQUIRE, "agent");
            xb_add(&bar[XB_XGEN(b.x)], 1u);
            asm volatile("s_waitcnt vmcnt(0)" ::: "memory");
        } else {
            XB_SPIN(xb_ld(&bar[XB_XGEN(b.x)]) == gen, bar);
            __builtin_amdgcn_fence(__ATOMIC_ACQUIRE, "agent");
            asm volatile("s_waitcnt vmcnt(0)" ::: "memory");
        }
    }
    __syncthreads();
}

namespace pg8 {
constexpr int BM = 256, BK = 64, HALF = 128, HTB = HALF * BK * 2, STAGE_BYTES = 8 * HTB, NXCD = 8, WGM = 8;
__host__ __device__ __forceinline__ int lds_byte(int r, int c) { const int st = (r >> 4) * 2 + (c >> 5), rr = r & 15, cc = c & 31, ob = rr * 64 + cc * 2; return st * 1024 + (ob ^ (((ob >> 9) & 1) << 5)); }
__host__ __device__ __forceinline__ void stage_rc(int b, int& R, int& C) { const int st = b / 1024, sb = b % 1024, swz = sb ^ (((sb >> 9) & 1) << 5); R = (st >> 1) * 16 + swz / 64; C = (st & 1) * 32 + (swz % 64) / 2; }
__host__ __device__ __forceinline__ int perm32(int rho) { const int n = rho >> 4, i = rho & 15; return 8 * (i >> 2) + 4 * n + (i & 3); }

struct Unit { int pm, pn, e, slot0; };

struct DenseSched {
    static constexpr bool UNIT_VOFF = false;
    const char* A; const char* Bt; int lda, ldbv; int nM, nN, nwg, G, c;
    __device__ __forceinline__ void init(const void* A_, int lda_, const void* Bt_, int ldb_, int M, int N, int G_, int c_) { A = (const char*)A_; Bt = (const char*)Bt_; lda = lda_; ldbv = ldb_; nM = M / BM; nN = N / BM; nwg = nM * nN; G = G_; c = c_; }
    __device__ __forceinline__ bool next(int i, Unit& u) const {
        const long L = (long)i * G + c; if (L >= nwg) return false;
        int wgid = (int)L; { const int q = nwg / NXCD, r = nwg % NXCD, xcd = wgid % NXCD, off = wgid / NXCD; wgid = (xcd < r ? xcd * (q + 1) : r * (q + 1) + (xcd - r) * q) + off; }
        const int nig = WGM * nN, gid = wgid / nig, fm = gid * WGM, gsz = (nM - fm) < WGM ? (nM - fm) : WGM;
        u.pm = fm + ((wgid % nig) % gsz); u.pn = (wgid % nig) / gsz; u.e = 0; u.slot0 = 0; return true;
    }
    __device__ __forceinline__ const char* a_base(const Unit& u) const { return A + (size_t)u.pm * 256 * lda * 2; }
    __device__ __forceinline__ unsigned a_voff(const Unit&, int row, int col) const { return (unsigned)(row * lda + col) * 2u; }
    __device__ __forceinline__ size_t a_hstep() const { return (size_t)128 * lda * 2; }
    __device__ __forceinline__ const char* b_base(const Unit& u) const { return Bt + (size_t)u.pn * 256 * ldbv * 2; }
    __device__ __forceinline__ int ldb() const { return ldbv; }
};

struct MoeSched {
    static constexpr bool UNIT_VOFF = true;
    const char* A; const char* Bt; int lda, ldbv; size_t b_estride; int npn_shift; int nblk_r; int G, c; const int* slot_tok; const LAS unsigned char* blk_e; bool gather;
    __device__ __forceinline__ bool next(int i, Unit& u) const {
        const long L = (long)i * G + c; const int blk = (int)(L >> npn_shift); if (blk >= nblk_r + 128) return false;
        u.pn = (int)(L & ((1 << npn_shift) - 1)); u.pm = blk;
        if (blk < nblk_r) { u.e = blk_e[blk]; u.slot0 = blk * 256; } else { u.e = 64; u.slot0 = SH_SLOT0 + (blk - nblk_r) * 256; }
        return true;
    }
    __device__ __forceinline__ const char* a_base(const Unit& u) const { return gather ? A : A + (size_t)u.slot0 * lda * 2; }
    __device__ __forceinline__ unsigned a_voff(const Unit& u, int row, int col) const {
        if (gather) { int tok; if (u.e == 64) tok = u.slot0 - SH_SLOT0 + row; else { tok = slot_tok[u.slot0 + row]; tok = tok < 0 ? 0 : tok; } return (unsigned)(tok * lda + col) * 2u; }
        return (unsigned)(row * lda + col) * 2u;
    }
    __device__ __forceinline__ size_t a_hstep() const { return 0; }
    __device__ __forceinline__ const char* b_base(const Unit& u) const { return Bt + (size_t)u.e * b_estride + (size_t)u.pn * 256 * ldbv * 2; }
    __device__ __forceinline__ int ldb() const { return ldbv; }
};

struct EpiBf16 {
    static constexpr bool PERM = true;
    bf16_t* O; int ldc;
    __device__ __forceinline__ void operator()(const f32x4 (&acc)[2][2][4][2], const Unit& u, int wr, int wc, int fr, int fq) const {
        const int row0 = u.pm * BM + wr * 64 + fr, col0 = u.pn * BM + wc * 32 + 8 * fq;
#pragma unroll
        for (int ai = 0; ai < 2; ++ai)
#pragma unroll
            for (int m = 0; m < 4; ++m) { bf16_t* rowp = O + (size_t)(row0 + ai * HALF + m * 16) * ldc + col0;
#pragma unroll
                for (int bj = 0; bj < 2; ++bj) { const f32x4 v0 = acc[ai][bj][m][0], v1 = acc[ai][bj][m][1];
                    u32x4 w; w.x = cvt_pk_bf16(v0[0], v0[1]); w.y = cvt_pk_bf16(v0[2], v0[3]); w.z = cvt_pk_bf16(v1[0], v1[1]); w.w = cvt_pk_bf16(v1[2], v1[3]);
                    *(u32x4*)(rowp + bj * HALF) = w; } }
    }
};
struct EpiKV {
    static constexpr bool PERM = true;
    bf16_t* Kf; bf16_t* V;
    __device__ __forceinline__ void operator()(const f32x4 (&acc)[2][2][4][2], const Unit& u, int wr, int wc, int fr, int fq) const {
        const int row0 = u.pm * BM + wr * 64 + fr; const bool isK = wc < 2;
        bf16_t* Bp = isK ? Kf : V; const int pitch = isK ? 1536 : 1024, hw = isK ? 96 : 64; const int wi = (wc & 1) * 32 + 8 * fq;
#pragma unroll
        for (int ai = 0; ai < 2; ++ai)
#pragma unroll
            for (int m = 0; m < 4; ++m) { bf16_t* rowp = Bp + (size_t)(row0 + ai * HALF + m * 16) * pitch + (u.pn * 2) * hw + wi;
#pragma unroll
                for (int bj = 0; bj < 2; ++bj) { const f32x4 v0 = acc[ai][bj][m][0], v1 = acc[ai][bj][m][1];
                    u32x4 w; w.x = cvt_pk_bf16(v0[0], v0[1]); w.y = cvt_pk_bf16(v0[2], v0[3]); w.z = cvt_pk_bf16(v1[0], v1[1]); w.w = cvt_pk_bf16(v1[2], v1[3]);
                    *(u32x4*)(rowp + bj * hw) = w; } }
    }
};
struct EpiRouter {
    static constexpr bool PERM = false;
    float* C;
    __device__ __forceinline__ void operator()(const f32x4 (&acc)[2][2][4][2], const Unit& u, int wr, int wc, int fr, int fq) const {
        if (u.pn != 0 || wc >= 2) return;
        const int row0 = u.pm * BM + wr * 64 + fr, col0 = wc * 32 + 4 * fq;
#pragma unroll
        for (int ai = 0; ai < 2; ++ai)
#pragma unroll
            for (int m = 0; m < 4; ++m) { float* rowp = C + (size_t)(row0 + ai * HALF + m * 16) * 64 + col0;
#pragma unroll
                for (int n = 0; n < 2; ++n) *(f32x4*)(rowp + n * 16) = acc[ai][0][m][n]; }
    }
};
struct EpiResid {
    static constexpr bool PERM = false;
    const bf16_t* Hb; float* Y;
    __device__ __forceinline__ void operator()(const f32x4 (&acc)[2][2][4][2], const Unit& u, int wr, int wc, int fr, int fq) const {
        const int row0 = u.pm * BM + wr * 64 + fr, col0 = u.pn * BM + wc * 32 + 4 * fq;
#pragma unroll
        for (int ai = 0; ai < 2; ++ai)
#pragma unroll
            for (int m = 0; m < 4; ++m) { const size_t off = (size_t)(row0 + ai * HALF + m * 16) * DM + col0;
#pragma unroll
                for (int bj = 0; bj < 2; ++bj)
#pragma unroll
                    for (int n = 0; n < 2; ++n) { const u32x2 hb = *(const u32x2*)(Hb + off + bj * HALF + n * 16); const f32x4 a = acc[ai][bj][m][n];
                        f32x4 o; o[0] = DN_ALPHA * bflo(hb.x) + a[0]; o[1] = DN_ALPHA * bfhi(hb.x) + a[1]; o[2] = DN_ALPHA * bflo(hb.y) + a[2]; o[3] = DN_ALPHA * bfhi(hb.y) + a[3];
                        *(f32x4*)(Y + off + bj * HALF + n * 16) = o; } }
    }
};
__device__ __forceinline__ float silu_mul(float g, float u) { return g * __builtin_amdgcn_rcpf(1.0f + __builtin_amdgcn_exp2f(-g * LOG2E)) * u; }
struct EpiSwiglu {
    static constexpr bool PERM = true;
    bf16_t* H;
    __device__ __forceinline__ void operator()(const f32x4 (&acc)[2][2][4][2], const Unit& u, int wr, int wc, int fr, int fq) const {
        const int row0 = u.slot0 + wr * 64 + fr, col0 = u.pn * 128 + wc * 32 + 8 * fq;
#pragma unroll
        for (int ai = 0; ai < 2; ++ai)
#pragma unroll
            for (int m = 0; m < 4; ++m) { bf16_t* rowp = H + (size_t)(row0 + ai * HALF + m * 16) * 256 + col0;
                const f32x4 g0 = acc[ai][0][m][0], g1 = acc[ai][0][m][1], u0 = acc[ai][1][m][0], u1 = acc[ai][1][m][1];
                u32x4 w; w.x = cvt_pk_bf16(silu_mul(g0[0], u0[0]), silu_mul(g0[1], u0[1])); w.y = cvt_pk_bf16(silu_mul(g0[2], u0[2]), silu_mul(g0[3], u0[3]));
                w.z = cvt_pk_bf16(silu_mul(g1[0], u1[0]), silu_mul(g1[1], u1[1])); w.w = cvt_pk_bf16(silu_mul(g1[2], u1[2]), silu_mul(g1[3], u1[3]));
                *(u32x4*)rowp = w; }
    }
};
struct EpiDown {
    static constexpr bool PERM = true;
    bf16_t* YS; const float* slot_w;
    __device__ __forceinline__ void operator()(const f32x4 (&acc)[2][2][4][2], const Unit& u, int wr, int wc, int fr, int fq) const {
        const int row0 = u.slot0 + wr * 64 + fr, col0 = u.pn * BM + wc * 32 + 8 * fq;
#pragma unroll
        for (int ai = 0; ai < 2; ++ai)
#pragma unroll
            for (int m = 0; m < 4; ++m) { const int slot = row0 + ai * HALF + m * 16; const float w8 = (u.e == 64) ? 1.0f : slot_w[slot]; bf16_t* rowp = YS + (size_t)slot * 1024 + col0;
#pragma unroll
                for (int bj = 0; bj < 2; ++bj) { const f32x4 v0 = acc[ai][bj][m][0] * w8, v1 = acc[ai][bj][m][1] * w8;
                    u32x4 w; w.x = cvt_pk_bf16(v0[0], v0[1]); w.y = cvt_pk_bf16(v0[2], v0[3]); w.z = cvt_pk_bf16(v1[0], v1[1]); w.w = cvt_pk_bf16(v1[2], v1[3]);
                    *(u32x4*)(rowp + bj * HALF) = w; } }
    }
};

template <class Epi, class Sched>
__device__ __forceinline__ void gemm_phase(LAS unsigned char* lds, const Sched& S, const Epi& E, const int K, const int tid_in) {
    int tid_o = tid_in; asm volatile("" : "+v"(tid_o));
    const int tid = tid_o, wid = __builtin_amdgcn_readfirstlane(tid >> 6), lane = tid & 63, wr = wid >> 2, wc = wid & 3, fr = lane & 15, fq = lane >> 4;
    const int nt = K / BK;
    const int ldb = S.ldb();
    int Rr[2], Cc[2]; unsigned voffB[2];
#pragma unroll
    for (int i = 0; i < 2; ++i) { int R, C; stage_rc(tid * 16 + i * 8192, R, C); Rr[i] = R; Cc[i] = C; const int Rb = Epi::PERM ? ((R & ~31) + perm32(R & 31)) : R; voffB[i] = (unsigned)(Rb * ldb + C) * 2u; }
    const size_t kstep = (size_t)(BK * 2);
    const size_t hstepB = (size_t)HALF * ldb * 2;
    const unsigned ldsw = (unsigned)wid * 1024u;
    const int aoff = lds_byte(wr * 64 + fr, fq * 8), boff = lds_byte(wc * 32 + fr, fq * 8);
#define PG8_SA(b, h) (((b) * 2 + (h)) * HTB)
#define PG8_SB(b, h) ((4 + (b) * 2 + (h)) * HTB)
#define PG8_STAGE(bufoff, gbase, voff) do { _Pragma("unroll") for (int _i = 0; _i < 2; ++_i) \
        __builtin_amdgcn_global_load_lds((const unsigned*)((const char*)(gbase) + (voff)[_i]), (LAS unsigned*)(lds + (bufoff) + ldsw + _i * 8192), 16, 0, 0); } while (0)
#define PG8_LDA(dst, b, h) do { _Pragma("unroll") for (int m = 0; m < 4; ++m) _Pragma("unroll") for (int k = 0; k < 2; ++k) dst[m][k] = *(const LAS bf16x8*)(lds + PG8_SA(b, h) + aoff + m * 2048 + k * 1024); } while (0)
#define PG8_LDB(dst, b, h) do { _Pragma("unroll") for (int n = 0; n < 2; ++n) _Pragma("unroll") for (int k = 0; k < 2; ++k) dst[n][k] = *(const LAS bf16x8*)(lds + PG8_SB(b, h) + boff + n * 2048 + k * 1024); } while (0)
#define PG8_MMA(ai, bj, At, Bt) do { __builtin_amdgcn_s_setprio(1); _Pragma("unroll") for (int m = 0; m < 4; ++m) _Pragma("unroll") for (int n = 0; n < 2; ++n) _Pragma("unroll") for (int k = 0; k < 2; ++k) \
        acc[ai][bj][m][n] = __builtin_amdgcn_mfma_f32_16x16x32_bf16(Bt[n][k], At[m][k], acc[ai][bj][m][n], 0, 0, 0); __builtin_amdgcn_s_setprio(0); } while (0)
#define PG8_WAIT_V(n) asm volatile("s_waitcnt vmcnt(" #n ")" ::: "memory")
#define PG8_WAIT_L(n) asm volatile("s_waitcnt lgkmcnt(" #n ")" ::: "memory")
#define PG8_BAR __builtin_amdgcn_s_barrier()
#define PG8_SCHED __builtin_amdgcn_sched_barrier(0)
    Unit cur, nxt; int ui = 0;
    if (!S.next(0, cur)) return;
    f32x4 acc[2][2][4][2];
#pragma unroll
    for (int a = 0; a < 2; ++a)
#pragma unroll
        for (int b = 0; b < 2; ++b)
#pragma unroll
            for (int m = 0; m < 4; ++m)
#pragma unroll
                for (int n = 0; n < 2; ++n) acc[a][b][m][n] = (f32x4){0.f, 0.f, 0.f, 0.f};
    bf16x8 At[4][2], B0[2][2], B1[2][2];
    unsigned vAc0[2], vAc1[2];
#pragma unroll
    for (int i = 0; i < 2; ++i) { vAc0[i] = S.a_voff(cur, Rr[i], Cc[i]); vAc1[i] = Sched::UNIT_VOFF ? S.a_voff(cur, HALF + Rr[i], Cc[i]) : 0u; }
    const size_t hstepA = Sched::UNIT_VOFF ? (size_t)0 : S.a_hstep();
#define PG8_VA1 (Sched::UNIT_VOFF ? vAc1 : vAc0)
    const char* cA = S.a_base(cur); const char* cB = S.b_base(cur);
    PG8_STAGE(PG8_SB(0, 0), cB, voffB); PG8_STAGE(PG8_SA(0, 0), cA, vAc0); PG8_STAGE(PG8_SB(0, 1), cB + hstepB, voffB); PG8_STAGE(PG8_SA(0, 1), cA + hstepA, PG8_VA1);
    if (wr == 1) PG8_BAR;
    PG8_WAIT_V(4); PG8_BAR;
    PG8_STAGE(PG8_SB(1, 0), cB + kstep, voffB); PG8_STAGE(PG8_SA(1, 0), cA + kstep, vAc0); PG8_STAGE(PG8_SB(1, 1), cB + hstepB + kstep, voffB);
    PG8_WAIT_V(6); PG8_BAR;
    for (;;) {
        const bool has_next = S.next(ui + 1, nxt);
        const char* nA = cA; const char* nB = cB;
        if (has_next) { nA = S.a_base(nxt); nB = S.b_base(nxt); }
        for (int t = 0; t < nt; t += 2) {
            const bool last = (t == nt - 2);
            const char* a1 = cA + (size_t)(t + 1) * kstep;
            const char* a2 = last ? nA : cA + (size_t)(t + 2) * kstep; const char* b2 = last ? nB : cB + (size_t)(t + 2) * kstep;
            const char* a3 = a2 + kstep; const char* b3 = b2 + kstep;
            asm volatile("" : "+s"(a1), "+s"(a2), "+s"(a3), "+s"(b2), "+s"(b3));
            PG8_LDB(B0, 0, 0); PG8_SCHED; PG8_LDA(At, 0, 0); PG8_STAGE(PG8_SA(1, 1), a1 + hstepA, PG8_VA1);
            if (Sched::UNIT_VOFF) { if (last && has_next) {
#pragma unroll
                for (int i = 0; i < 2; ++i) { vAc0[i] = S.a_voff(nxt, Rr[i], Cc[i]); vAc1[i] = S.a_voff(nxt, HALF + Rr[i], Cc[i]); } } }
            PG8_WAIT_L(8); PG8_BAR; PG8_WAIT_L(0); PG8_MMA(0, 0, At, B0); PG8_BAR; PG8_SCHED;
            PG8_LDB(B1, 0, 1); PG8_STAGE(PG8_SB(0, 0), b2, voffB);
            PG8_BAR; PG8_WAIT_L(0); PG8_MMA(0, 1, At, B1); PG8_BAR;
            PG8_LDA(At, 0, 1); PG8_STAGE(PG8_SA(0, 0), a2, vAc0);
            PG8_BAR; PG8_WAIT_L(0); PG8_MMA(1, 0, At, B0); PG8_BAR; PG8_SCHED;
            PG8_STAGE(PG8_SB(0, 1), b2 + hstepB, voffB);
            PG8_WAIT_V(6); PG8_BAR; PG8_MMA(1, 1, At, B1); PG8_BAR;
            PG8_LDB(B0, 1, 0); PG8_SCHED; PG8_LDA(At, 1, 0); PG8_STAGE(PG8_SA(0, 1), a2 + hstepA, PG8_VA1);
            PG8_WAIT_L(8); PG8_BAR; PG8_WAIT_L(0); PG8_MMA(0, 0, At, B0); PG8_BAR; PG8_SCHED;
            PG8_LDB(B1, 1, 1); PG8_STAGE(PG8_SB(1, 0), b3, voffB);
            PG8_BAR; PG8_WAIT_L(0); PG8_MMA(0, 1, At, B1); PG8_BAR;
            PG8_LDA(At, 1, 1); PG8_STAGE(PG8_SA(1, 0), a3, vAc0);
            PG8_BAR; PG8_WAIT_L(0); PG8_MMA(1, 0, At, B0); PG8_BAR; PG8_SCHED;
            PG8_STAGE(PG8_SB(1, 1), b3 + hstepB, voffB);
            PG8_WAIT_V(6); PG8_BAR; PG8_MMA(1, 1, At, B1); PG8_BAR;
        }
        E(acc, cur, wr, wc, fr, fq);
        if (!has_next) break;
#pragma unroll
        for (int a = 0; a < 2; ++a)
#pragma unroll
            for (int b = 0; b < 2; ++b)
#pragma unroll
                for (int m = 0; m < 4; ++m)
#pragma unroll
                    for (int n = 0; n < 2; ++n) acc[a][b][m][n] = (f32x4){0.f, 0.f, 0.f, 0.f};
        cur = nxt; cA = nA; cB = nB; ++ui;
    }
    PG8_WAIT_V(0);
    if (wr == 0) PG8_BAR;
    PG8_BAR;
#undef PG8_SA
#undef PG8_VA1
#undef PG8_SB
#undef PG8_STAGE
#undef PG8_LDA
#undef PG8_LDB
#undef PG8_MMA
#undef PG8_WAIT_V
#undef PG8_WAIT_L
#undef PG8_BAR
#undef PG8_SCHED
}
}

typedef short v4i16_t __attribute__((ext_vector_type(4)));
__device__ __forceinline__ s16x4 vtr(const LAS char* p) { return __builtin_bit_cast(s16x4, __builtin_amdgcn_ds_read_tr16_b64_v4i16((LAS v4i16_t*)p)); }

template <int DQK, int DV, class F>
__device__ __forceinline__ void attn_wave32(const bf16_t* __restrict__ Qp, long qs, const bf16_t* __restrict__ Kp, long ks, const bf16_t* __restrict__ Vp, long vs,
                                            int kt0, int kt1, int kmax, const F& f, bf16_t* Op, long os, float* lsep, long lses, LAS char* vl, int lane) {
    constexpr int NS = DQK / 16, NC = DV / 32, CH = DV / 8, VP = (DV == 64) ? 192 : 320, NLD = 32 * CH / 64;
    const int r32 = lane & 31, hi = lane >> 5;
    bf16x8 qf[NS];
#pragma unroll
    for (int s = 0; s < NS; ++s) qf[s] = *(const bf16x8*)(Qp + (long)r32 * qs + 16 * s + 8 * hi);
    f.fix_q(qf, r32, hi);
    f32x16 o[NC];
#pragma unroll
    for (int c = 0; c < NC; ++c)
#pragma unroll
        for (int r = 0; r < 16; ++r) o[c][r] = 0.f;
    float m_run = NEGF, l_run = 0.f;
    const int blk = (lane >> 4) & 1, q4 = (lane & 15) >> 2, p4 = lane & 3;
    const LAS char* vrd = vl + (4 * hi + q4) * VP + (16 * blk + 4 * p4) * 2;
    for (int kt = kt0; kt < kt1; ++kt) {
        const int k0 = kt * 32;
        int krow = k0 + r32; krow = krow > kmax ? kmax : krow;
        const bf16_t* kr = Kp + (long)krow * ks + 8 * hi;
        f32x16 acc;
#pragma unroll
        for (int r = 0; r < 16; ++r) acc[r] = 0.f;
#pragma unroll
        for (int s = 0; s < NS; ++s) { const bf16x8 kf = *(const bf16x8*)(kr + 16 * s); acc = __builtin_amdgcn_mfma_f32_32x32x16_bf16(kf, qf[s], acc, 0, 0, 0); }
#pragma unroll
        for (int i = 0; i < NLD; ++i) { const int idx = lane + 64 * i, row = idx / CH, ch = idx % CH; int vrow = k0 + row; vrow = vrow > kmax ? kmax : vrow;
            const u32x4 v = *(const u32x4*)(Vp + (long)vrow * vs + ch * 8); *(LAS u32x4*)(vl + row * VP + ch * 16) = v; }
        const unsigned ctx = f.tile_ctx(kt, r32);
        float s[16]; float mx = NEGF;
#pragma unroll
        for (int r = 0; r < 16; ++r) { s[r] = f.logit(acc[r], k0 + crow(r, hi), r32, ctx); mx = fmaxf(mx, s[r]); }
        mx = swapmax(mx);
        const float m_new = fmaxf(m_run, mx);
        const float alpha = __builtin_amdgcn_exp2f(m_run - m_new);
        float ls = 0.f;
#pragma unroll
        for (int r = 0; r < 16; ++r) { const float pv = (s[r] > -1.0e29f) ? __builtin_amdgcn_exp2f(s[r] - m_new) : 0.f; s[r] = pv; ls += pv; }
        l_run = l_run * alpha + ls; m_run = m_new;
#pragma unroll
        for (int c = 0; c < NC; ++c)
#pragma unroll
            for (int r = 0; r < 16; ++r) o[c][r] *= alpha;
        bf16x8 pb[2];
#pragma unroll
        for (int j = 0; j < 2; ++j) { u32x4 w; w.x = cvt_pk_bf16(s[8 * j + 0], s[8 * j + 1]); w.y = cvt_pk_bf16(s[8 * j + 2], s[8 * j + 3]); w.z = cvt_pk_bf16(s[8 * j + 4], s[8 * j + 5]); w.w = cvt_pk_bf16(s[8 * j + 6], s[8 * j + 7]); pb[j] = __builtin_bit_cast(bf16x8, w); }
#pragma unroll
        for (int c = 0; c < NC; ++c)
#pragma unroll
            for (int j = 0; j < 2; ++j) {
                const s16x4 lo = vtr(vrd + (16 * j) * VP + 64 * c), h4 = vtr(vrd + (16 * j + 8) * VP + 64 * c);
                const bf16x8 vf = (bf16x8){lo[0], lo[1], lo[2], lo[3], h4[0], h4[1], h4[2], h4[3]};
                o[c] = __builtin_amdgcn_mfma_f32_32x32x16_bf16(vf, pb[j], o[c], 0, 0, 0);
            }
    }
    const float l_tot = swapadd2(l_run, l_run);
    const float inv = 1.0f / l_tot;
    bf16_t* orow = Op + (long)r32 * os;
#pragma unroll
    for (int c = 0; c < NC; ++c)
#pragma unroll
        for (int g = 0; g < 4; ++g) { u32x2 w; w.x = cvt_pk_bf16(o[c][4 * g] * inv, o[c][4 * g + 1] * inv); w.y = cvt_pk_bf16(o[c][4 * g + 2] * inv, o[c][4 * g + 3] * inv);
            *(u32x2*)(orow + 32 * c + 8 * g + 4 * hi) = w; }
    if (lsep != nullptr && hi == 0) lsep[(long)r32 * lses] = (m_run + __builtin_amdgcn_logf(l_tot)) * LN2F;
}

struct FnMLA {
    int t0; float sc;
    __device__ __forceinline__ void fix_q(bf16x8 (&qf)[6], int r32, int hi) const {
        const float pos = (float)(t0 + r32);
#pragma unroll
        for (int j = 0; j < 8; ++j) { const int i = 8 * hi + j; const float inv = exp2f(-(float)i * (13.287712379549449f / 16.0f)); const float ang = pos * inv; float sn, cs; sincosf(ang, &sn, &cs);
            const float x1 = bf2f((bf16_t)qf[4][j]), x2 = bf2f((bf16_t)qf[5][j]); qf[4][j] = (short)f2bf(x1 * cs - x2 * sn); qf[5][j] = (short)f2bf(x1 * sn + x2 * cs); }
    }
    __device__ __forceinline__ unsigned tile_ctx(int, int) const { return 0u; }
    __device__ __forceinline__ float logit(float a, int key, int r32, unsigned) const { return (key <= t0 + r32) ? a * sc : NEGF; }
};
struct FnDil {
    int i0; float sc; const float* tab;
    template <int N> __device__ __forceinline__ void fix_q(bf16x8 (&)[N], int, int) const {}
    __device__ __forceinline__ unsigned tile_ctx(int, int) const { return 0u; }
    __device__ __forceinline__ float logit(float a, int key, int r32, unsigned) const { const int d = i0 + r32 - key; const bool ok = (d >= 0) && (d <= 128); const int dc = ok ? d : 0; return ok ? a * sc + tab[dc] : NEGF; }
};
struct FnDsa {
    int t0; float sc; const float* tab; const unsigned* bm;
    template <int N> __device__ __forceinline__ void fix_q(bf16x8 (&)[N], int, int) const {}
    __device__ __forceinline__ unsigned tile_ctx(int kt, int r32) const { return bm[(long)r32 * 64 + kt]; }
    __device__ __forceinline__ float logit(float a, int key, int r32, unsigned ctx) const { const int d = t0 + r32 - key; const bool ok = ((ctx >> (key & 31)) & 1u) != 0u && d >= 0; const int dc = ok ? d : 0; return ok ? a * sc + tab[dc] : NEGF; }
};

__device__ __forceinline__ unsigned halfsum32(unsigned v) { v += __shfl_xor(v, 16); v += __shfl_xor(v, 8); v += __shfl_xor(v, 4); v += __shfl_xor(v, 2); v += __shfl_xor(v, 1); return v; }
__device__ __forceinline__ unsigned ord_u32(float f) { const unsigned u = __float_as_uint(f); return (u & 0x80000000u) ? ~u : (u | 0x80000000u); }
__device__ __forceinline__ void score_wave(const bf16_t* __restrict__ P, float* __restrict__ scores, int b, int t0, int lane) {
    const int r32 = lane & 31, hi = lane >> 5;
    const long rowb = (long)b * SEQ;
    const bf16_t* qrow = P + (rowb + t0 + (r32 >> 3)) * 3072 + 2304 + (r32 & 7) * 64 + 8 * hi;
    bf16x8 qf[4];
#pragma unroll
    for (int s = 0; s < 4; ++s) qf[s] = *(const bf16x8*)(qrow + 16 * s);
    float w[16];
#pragma unroll
    for (int r = 0; r < 16; ++r) w[r] = bf2f(P[(rowb + t0 + (r >> 2)) * 3072 + 2880 + (r & 3) + 4 * hi]) * (0.125f * 0.35355339059327373f);
    const int tA = t0 + 2 * hi, tB = tA + 1;
    const int nkt = (t0 + 3) / 32 + 1;
    float* sAo = scores + (rowb + tA) * SEQ + r32; float* sBo = scores + (rowb + tB) * SEQ + r32;
    for (int kt = 0; kt < nkt; ++kt) {
        const bf16_t* kr = P + (rowb + kt * 32 + r32) * 3072 + 2816 + 8 * hi;
        f32x16 acc;
#pragma unroll
        for (int r = 0; r < 16; ++r) acc[r] = 0.f;
#pragma unroll
        for (int s = 0; s < 4; ++s) { const bf16x8 kf = *(const bf16x8*)(kr + 16 * s); acc = __builtin_amdgcn_mfma_f32_32x32x16_bf16(qf[s], kf, acc, 0, 0, 0); }
        float p[4];
#pragma unroll
        for (int q = 0; q < 4; ++q) { float a = 0.f;
#pragma unroll
            for (int i = 0; i < 4; ++i) a += w[4 * q + i] * fmaxf(acc[4 * q + i], 0.f);
            p[q] = a; }
        const float sA = swapadd2(p[0], p[2]), sB = swapadd2(p[1], p[3]);
        sAo[kt * 32] = sA; sBo[kt * 32] = sB;
    }
}
__device__ __forceinline__ void select_wave(const float* __restrict__ scores, unsigned* __restrict__ bitmask, int b, int t, int lane) {
    const long row = (long)b * SEQ + t;
    unsigned long long* bm = (unsigned long long*)(bitmask + row * 64);
    if (t < 256) { const int lo = 64 * lane; if (lane < 32) bm[lane] = (t >= lo + 63) ? ~0ull : ((t < lo) ? 0ull : ((2ull << (t - lo)) - 1ull)); return; }
    const float* sr = scores + row * SEQ;
    unsigned u[32];
#pragma unroll
    for (int j = 0; j < 32; ++j) { const int key = 64 * j + lane; float v = 0.f; if (64 * j <= t) v = sr[key]; u[j] = (key <= t) ? ord_u32(v) : 0u; }
    unsigned thr = 0u;
    for (int bit = 31; bit >= 0; --bit) {
        const unsigned c = thr | (1u << bit); int n = 0;
#pragma unroll
        for (int j = 0; j < 32; ++j) n += __popcll(__ballot(u[j] >= c));
        thr = (n >= 256) ? c : thr;
    }
    int g = 0;
#pragma unroll
    for (int j = 0; j < 32; ++j) g += __popcll(__ballot(u[j] > thr));
    const int need = 256 - g; int eq = 0;
    const unsigned long long lt = (1ull << lane) - 1ull;
#pragma unroll
    for (int j = 0; j < 32; ++j) {
        const bool isEq = (u[j] == thr); const unsigned long long be = __ballot(isEq);
        const bool sel = (u[j] > thr) || (isEq && (eq + __popcll(be & lt) < need));
        eq += __popcll(be);
        const unsigned long long bs = __ballot(sel);
        if (lane == 0) bm[j] = bs;
    }
}

__device__ __forceinline__ int t5_bucket(int dist) {
    if (dist < 16) return dist;
    const float df = (float)dist;
    int large = 16 + (int)(logf(df / 16.0f) / logf(128.0f) * 16.0f);
    return large < 31 ? large : 31;
}

__device__ __forceinline__ void cvt_run(const float* __restrict__ src, bf16_t* __restrict__ dst, int K, int N, int Kout, int Nloop, int nb, size_t sbs, size_t dbs, int rchunk, int rstride, int rbase, LAS float* tile, const int tid, const int bid) {
    const int tk = Kout / 64, tn = Nloop / 64, per = tk * tn; const long total = (long)per * nb;
    for (long tix = bid; tix < total; tix += GRID) {
        const int b = (int)(tix / per), r = (int)(tix % per), kt = r % tk, ntile = r / tk, k0 = kt * 64, n0 = ntile * 64;
#pragma unroll
        for (int pass = 0; pass < 2; ++pass) { const int kk = pass * 32 + (tid >> 4), nn = (tid & 15) * 4, k = k0 + kk, n = n0 + nn;
            f32x4 v = (f32x4){0.f, 0.f, 0.f, 0.f}; if (k < K && n < N) v = *(const f32x4*)(src + (size_t)b * sbs + (size_t)k * N + n);
            tile[kk * 65 + nn] = v[0]; tile[kk * 65 + nn + 1] = v[1]; tile[kk * 65 + nn + 2] = v[2]; tile[kk * 65 + nn + 3] = v[3]; }
        __syncthreads();
        { const int nn = tid >> 3, kk8 = (tid & 7) * 8, n = n0 + nn; const int row = rbase + (n / rchunk) * rstride + (n % rchunk);
            u32x4 w; w.x = cvt_pk_bf16(tile[(kk8 + 0) * 65 + nn], tile[(kk8 + 1) * 65 + nn]); w.y = cvt_pk_bf16(tile[(kk8 + 2) * 65 + nn], tile[(kk8 + 3) * 65 + nn]);
            w.z = cvt_pk_bf16(tile[(kk8 + 4) * 65 + nn], tile[(kk8 + 5) * 65 + nn]); w.w = cvt_pk_bf16(tile[(kk8 + 6) * 65 + nn], tile[(kk8 + 7) * 65 + nn]);
            *(u32x4*)(dst + (size_t)b * dbs + (size_t)row * Kout + k0 + kk8) = w; }
        __syncthreads();
    }
}

__device__ __forceinline__ void ln1_phase(const float* __restrict__ Y, const float* __restrict__ g, const float* __restrict__ bta, bf16_t* __restrict__ HB, int gw, int lane) {
    f32x4 gv[4], bv[4];
#pragma unroll
    for (int j = 0; j < 4; ++j) { gv[j] = *(const f32x4*)(g + j * 256 + lane * 4); bv[j] = *(const f32x4*)(bta + j * 256 + lane * 4); }
    for (int row = gw; row < T; row += NWAVES_TOTAL) {
        f32x4 x[4]; float s = 0.f;
#pragma unroll
        for (int j = 0; j < 4; ++j) { x[j] = *(const f32x4*)(Y + (size_t)row * DM + j * 256 + lane * 4); s += (x[j][0] + x[j][1]) + (x[j][2] + x[j][3]); }
#pragma unroll
        for (int o = 32; o >= 1; o >>= 1) s += __shfl_xor(s, o);
        const float mu = s * (1.0f / 1024.0f); float q = 0.f;
#pragma unroll
        for (int j = 0; j < 4; ++j) { x[j] = x[j] - mu; q += (x[j][0] * x[j][0] + x[j][1] * x[j][1]) + (x[j][2] * x[j][2] + x[j][3] * x[j][3]); }
#pragma unroll
        for (int o = 32; o >= 1; o >>= 1) q += __shfl_xor(q, o);
        const float rstd = rsqrtf(q * (1.0f / 1024.0f) + 1e-5f);
#pragma unroll
        for (int j = 0; j < 4; ++j) { const f32x4 y = x[j] * rstd * gv[j] + bv[j]; u32x2 w; w.x = cvt_pk_bf16(y[0], y[1]); w.y = cvt_pk_bf16(y[2], y[3]); *(u32x2*)(HB + (size_t)row * DM + j * 256 + lane * 4) = w; }
    }
}
__device__ __forceinline__ void ln2_phase(const bf16_t* __restrict__ YS, const int* __restrict__ a_slot, const float* __restrict__ g, const float* __restrict__ bta, bf16_t* HB, float* outp, int gw, int lane) {
    f32x4 gv[4], bv[4];
#pragma unroll
    for (int j = 0; j < 4; ++j) { gv[j] = *(const f32x4*)(g + j * 256 + lane * 4); bv[j] = *(const f32x4*)(bta + j * 256 + lane * 4); }
    for (int row = gw; row < T; row += NWAVES_TOTAL) {
        f32x4 x[4]; float s = 0.f;
#pragma unroll
        for (int j = 0; j < 4; ++j) { const u32x2 hb = *(const u32x2*)(HB + (size_t)row * DM + j * 256 + lane * 4); x[j][0] = DN_ALPHA * bflo(hb.x); x[j][1] = DN_ALPHA * bfhi(hb.x); x[j][2] = DN_ALPHA * bflo(hb.y); x[j][3] = DN_ALPHA * bfhi(hb.y); }
#pragma unroll
        for (int k = 0; k < 9; ++k) { const int slot = (k < 8) ? a_slot[row * 8 + k] : (SH_SLOT0 + row); const bf16_t* yr = YS + (size_t)slot * 1024 + lane * 4;
#pragma unroll
            for (int j = 0; j < 4; ++j) { const u32x2 yv = *(const u32x2*)(yr + j * 256); x[j][0] += bflo(yv.x); x[j][1] += bfhi(yv.x); x[j][2] += bflo(yv.y); x[j][3] += bfhi(yv.y); } }
#pragma unroll
        for (int j = 0; j < 4; ++j) s += (x[j][0] + x[j][1]) + (x[j][2] + x[j][3]);
#pragma unroll
        for (int o = 32; o >= 1; o >>= 1) s += __shfl_xor(s, o);
        const float mu = s * (1.0f / 1024.0f); float q = 0.f;
#pragma unroll
        for (int j = 0; j < 4; ++j) { x[j] = x[j] - mu; q += (x[j][0] * x[j][0] + x[j][1] * x[j][1]) + (x[j][2] * x[j][2] + x[j][3] * x[j][3]); }
#pragma unroll
        for (int o = 32; o >= 1; o >>= 1) q += __shfl_xor(q, o);
        const float rstd = rsqrtf(q * (1.0f / 1024.0f) + 1e-5f);
#pragma unroll
        for (int j = 0; j < 4; ++j) { const f32x4 y = x[j] * rstd * gv[j] + bv[j];
            if (outp != nullptr) *(f32x4*)(outp + (size_t)row * DM + j * 256 + lane * 4) = y;
            else { u32x2 w; w.x = cvt_pk_bf16(y[0], y[1]); w.y = cvt_pk_bf16(y[2], y[3]); *(u32x2*)(HB + (size_t)row * DM + j * 256 + lane * 4) = w; } }
    }
}

__device__ __forceinline__ void route_phase(const float* __restrict__ logits, const float* __restrict__ ebias, int* __restrict__ a_e, float* __restrict__ a_g, int* __restrict__ a_pos, int* __restrict__ whist, int gw, int lane) {
    const float eb = ebias[lane];
    int mycnt = 0;
    for (int i = 0; i < 16; ++i) {
        const int t = gw * 16 + i;
        const float lg = logits[(size_t)t * 64 + lane];
        const float sg = 1.0f / (1.0f + expf(-lg));
        const float c = sg + eb;
        float m1 = c; m1 = fmaxf(m1, __shfl_xor(m1, 1)); m1 = fmaxf(m1, __shfl_xor(m1, 2)); m1 = fmaxf(m1, __shfl_xor(m1, 4));
        int i1 = (c == m1) ? lane : 999; i1 = min(i1, __shfl_xor(i1, 1)); i1 = min(i1, __shfl_xor(i1, 2)); i1 = min(i1, __shfl_xor(i1, 4));
        float m2 = (lane == i1) ? -INFINITY : c; m2 = fmaxf(m2, __shfl_xor(m2, 1)); m2 = fmaxf(m2, __shfl_xor(m2, 2)); m2 = fmaxf(m2, __shfl_xor(m2, 4));
        const float gs = m1 + m2; const int myg = lane >> 3;
        int grank = 0;
#pragma unroll
        for (int g2 = 0; g2 < 8; ++g2) { const float v = __shfl(gs, g2 * 8); grank += (v > gs || (v == gs && g2 < myg)) ? 1 : 0; }
        const float cm = (grank < 4) ? c : -INFINITY;
        int rank = 0;
        for (int l2 = 0; l2 < 64; ++l2) { const float v = __shfl(cm, l2); rank += (v > cm || (v == cm && l2 < lane)) ? 1 : 0; }
        const bool sel = rank < 8;
        float ssum = sel ? sg : 0.f;
#pragma unroll
        for (int o = 32; o >= 1; o >>= 1) ssum += __shfl_xor(ssum, o);
        if (sel) { a_e[t * 8 + rank] = lane; a_g[t * 8 + rank] = sg / ssum * 2.5f; a_pos[t * 8 + rank] = mycnt; mycnt += 1; }
    }
    whist[gw * 64 + lane] = mycnt;
}

__device__ __forceinline__ void assign_phase(const int* __restrict__ whist, const int* __restrict__ a_e, const float* __restrict__ a_g, const int* __restrict__ a_pos, int* __restrict__ a_slot,
                                             int* __restrict__ slot_tok, float* __restrict__ slot_w, int* __restrict__ etot, LAS int* L, const int tid, const int bid) {
    LAS int* red = L; LAS int* red2 = L + 512; LAS int* tot = L + 1024; LAS int* pre = L + 1088; LAS int* pstart = L + 1152; LAS int* base = L + 1216;
    const int e = tid & 63, part = tid >> 6; const int gw0 = bid * 8;
    int s = 0, s2 = 0;
    for (int w = part * 256; w < part * 256 + 256; ++w) { const int v = whist[w * 64 + e]; s += v; s2 += (w < gw0) ? v : 0; }
    red[part * 64 + e] = s; red2[part * 64 + e] = s2;
    __syncthreads();
    if (tid < 64) { int a = 0, b2 = 0;
#pragma unroll
        for (int p2 = 0; p2 < 8; ++p2) { a += red[p2 * 64 + tid]; b2 += red2[p2 * 64 + tid]; }
        tot[tid] = a; pre[tid] = b2;
        const int padded = ((a + 255) >> 8) << 8; int inc = padded;
#pragma unroll
        for (int o = 1; o < 64; o <<= 1) { const int v = __shfl_up(inc, o); if (tid >= o) inc += v; }
        pstart[tid] = inc - padded;
        int run = b2;
        for (int w = 0; w < 8; ++w) { base[w * 64 + tid] = run; run += whist[(gw0 + w) * 64 + tid]; }
        if (bid == 0) etot[tid] = a;
    }
    __syncthreads();
    for (int idx = tid; idx < 1024; idx += NTHREADS) { const int tl = idx >> 3; const int t = bid * 128 + tl; const int ee = a_e[t * 8 + (idx & 7)];
        const int slot = pstart[ee] + base[(tl >> 4) * 64 + ee] + a_pos[t * 8 + (idx & 7)];
        a_slot[t * 8 + (idx & 7)] = slot; slot_tok[slot] = t; slot_w[slot] = a_g[t * 8 + (idx & 7)]; }
    if (bid < 64) { const int ee = bid; const int a = tot[ee], padded = ((a + 255) >> 8) << 8;
        for (int i = a + tid; i < padded; i += NTHREADS) { slot_tok[pstart[ee] + i] = -1; slot_w[pstart[ee] + i] = 0.f; } }
    __syncthreads();
}
__device__ __forceinline__ int build_blk_table(const int* __restrict__ etot, LAS unsigned char* blk_e, LAS int* nblk_p, const int tid) {
    __syncthreads();
    if (tid < 64) { const int nbk = (etot[tid] + 255) >> 8; int inc = nbk;
#pragma unroll
        for (int o = 1; o < 64; o <<= 1) { const int v = __shfl_up(inc, o); if (tid >= o) inc += v; }
        const int st = inc - nbk; for (int i = 0; i < nbk; ++i) blk_e[st + i] = (unsigned char)tid;
        if (tid == 63) *nblk_p = inc; }
    __syncthreads();
    return *nblk_p;
}

__device__ __forceinline__ void prepc_phase(const bf16_t* __restrict__ Pc, const float* __restrict__ qn, const float* __restrict__ kvn, bf16_t* __restrict__ Aq, bf16_t* __restrict__ Akv, bf16_t* __restrict__ Kf, int gw, int lane) {
    const f32x4 gq = *(const f32x4*)(qn + lane * 4); const f32x2 gk = *(const f32x2*)(kvn + lane * 2);
    for (int t = gw; t < T; t += NWAVES_TOTAL) {
        const bf16_t* pr = Pc + (size_t)t * 512;
        const u32x2 cq = *(const u32x2*)(pr + lane * 4); const unsigned ck = *(const unsigned*)(pr + 256 + lane * 2);
        float x0 = bflo(cq.x), x1 = bfhi(cq.x), x2 = bflo(cq.y), x3 = bfhi(cq.y); float sq = x0 * x0 + x1 * x1 + x2 * x2 + x3 * x3;
        float y0 = bflo(ck), y1 = bfhi(ck); float sk = y0 * y0 + y1 * y1;
#pragma unroll
        for (int o = 32; o >= 1; o >>= 1) { sq += __shfl_xor(sq, o); sk += __shfl_xor(sk, o); }
        const float rq = rsqrtf(sq * (1.0f / 256.0f) + 1e-6f), rk = rsqrtf(sk * (1.0f / 128.0f) + 1e-6f);
        u32x2 wq; wq.x = cvt_pk_bf16(x0 * rq * gq[0], x1 * rq * gq[1]); wq.y = cvt_pk_bf16(x2 * rq * gq[2], x3 * rq * gq[3]);
        *(u32x2*)(Aq + (size_t)t * 256 + lane * 4) = wq;
        *(unsigned*)(Akv + (size_t)t * 256 + lane * 2) = cvt_pk_bf16(y0 * rk * gk[0], y1 * rk * gk[1]);
        *(unsigned*)(Akv + (size_t)t * 256 + 128 + lane * 2) = 0u;
        const int h = lane >> 2, qd = lane & 3; const float pos = (float)(t & (SEQ - 1));
        const u32x2 ka = *(const u32x2*)(pr + 384 + 4 * qd), kb = *(const u32x2*)(pr + 400 + 4 * qd);
        const float a[4] = {bflo(ka.x), bfhi(ka.x), bflo(ka.y), bfhi(ka.y)}, bb[4] = {bflo(kb.x), bfhi(kb.x), bflo(kb.y), bfhi(kb.y)};
        float o1[4], o2[4];
#pragma unroll
        for (int j = 0; j < 4; ++j) { const int i = 4 * qd + j; const float inv = exp2f(-(float)i * (13.287712379549449f / 16.0f)); float sn, cs; sincosf(pos * inv, &sn, &cs); o1[j] = a[j] * cs - bb[j] * sn; o2[j] = a[j] * sn + bb[j] * cs; }
        u32x2 w1, w2; w1.x = cvt_pk_bf16(o1[0], o1[1]); w1.y = cvt_pk_bf16(o1[2], o1[3]); w2.x = cvt_pk_bf16(o2[0], o2[1]); w2.y = cvt_pk_bf16(o2[2], o2[3]);
        *(u32x2*)(Kf + (size_t)t * 1536 + h * 96 + 64 + 4 * qd) = w1; *(u32x2*)(Kf + (size_t)t * 1536 + h * 96 + 80 + 4 * qd) = w2;
    }
}
__device__ __forceinline__ void combine_phase(const bf16_t* __restrict__ Og, const float* __restrict__ lse, bf16_t* __restrict__ O, const int tid, const int bid) {
    const long n = (long)T * 16 * 8;
    for (long i = (long)bid * NTHREADS + tid; i < n; i += (long)GRID * NTHREADS) {
        const long th = i >> 3; const int ch = (int)(i & 7);
        const float l0 = lse[th], l1 = lse[(long)T * 16 + th], l2 = lse[2l * T * 16 + th];
        const float m = fmaxf(l0, fmaxf(l1, l2)); const float e0 = expf(l0 - m), e1 = expf(l1 - m), e2 = expf(l2 - m); const float inv = 1.0f / (e0 + e1 + e2);
        const float w0 = e0 * inv, w1 = e1 * inv, w2 = e2 * inv;
        const size_t off = (size_t)th * 64 + ch * 8;
        const u32x4 a = *(const u32x4*)(Og + off), b2 = *(const u32x4*)(Og + (size_t)T * 1024 + off), c2 = *(const u32x4*)(Og + 2 * (size_t)T * 1024 + off);
        u32x4 r;
#pragma unroll
        for (int j = 0; j < 4; ++j) { const float lo = w0 * bflo(a[j]) + w1 * bflo(b2[j]) + w2 * bflo(c2[j]); const float hi2 = w0 * bfhi(a[j]) + w1 * bfhi(b2[j]) + w2 * bfhi(c2[j]); r[j] = cvt_pk_bf16(lo, hi2); }
        *(u32x4*)(O + off) = r;
    }
}

struct Params {
    const float* x; const float* rel_bias; const float* a_w_in; const float* a_w_o; const float* b_w_in; const float* b_w_o; const float* c_w_in; const float* c_q_norm; const float* c_kv_norm;
    const float* c_w_q_up; const float* c_w_kv_up; const float* c_w_o; const float* ln_g; const float* ln_b; const float* moe_w_router; const float* moe_bias; const float* moe_w_gate; const float* moe_w_up;
    const float* moe_w_down; const float* moe_ws_gate; const float* moe_ws_up; const float* moe_ws_down;
    float* out; char* ws; int lo, hi;
};

__global__ void __launch_bounds__(NTHREADS, 2) fwd(Params p_) {
    extern __shared__ __attribute__((aligned(16))) unsigned char lds_raw[];
    LAS unsigned char* lds = (LAS unsigned char*)lds_raw;
    const int wid_s = __builtin_amdgcn_readfirstlane((int)threadIdx.x >> 6);
    if (threadIdx.x < 4) ((LAS unsigned*)(lds + LDS_BARW))[threadIdx.x] = 0u;
    __syncthreads();
    XcdBarrier bar = xcd_barrier_post((unsigned*)(p_.ws + WS_CTL), (volatile LAS unsigned*)(lds + LDS_BARW), wid_s);
    int ph = 0;
#define RUN (ph >= p_.lo && ph < p_.hi)
#define SEAM() do { const bool _b = (ph >= p_.lo) && (ph + 1 < p_.hi); ++ph; if (_b) xcd_barrier(bar); } while (0)
#define RV Params p = p_; { char* w_ = p.ws; asm volatile("" : "+s"(w_)); p.ws = w_; } char* ws = p.ws; int tid = wid_s * 64 + lane_id(); asm volatile("" : "+v"(tid)); int bid = blockIdx.x; asm volatile("" : "+s"(bid)); const int lane = tid & 63, wid = __builtin_amdgcn_readfirstlane(tid >> 6), gw = bid * 8 + wid; \
    bf16_t* HB = (bf16_t*)(ws + WS_HB); char* WB = ws + WS_WB; char* BIG = ws + WS_BIG; float* Y32 = (float*)(BIG + BIG_Y32); float* tabA = (float*)(ws + WS_TABA); float* tabB = (float*)(ws + WS_TABB); \
    LAS float* ctile = (LAS float*)(lds + LDS_STAGE); LAS unsigned char* blk_e = lds + LDS_BLK; LAS int* nblk_p = (LAS int*)(lds + LDS_NBLK); int* etot = (int*)(ws + WS_CTL + CTL_ETOT); \
    float* logits = (float*)(BIG + M_LOG); int* a_e = (int*)(BIG + M_AE); float* a_g = (float*)(BIG + M_AG); int* a_pos = (int*)(BIG + M_APOS); int* a_slot = (int*)(BIG + M_ASLOT); \
    int* whist = (int*)(BIG + M_WHIST); int* slot_tok = (int*)(BIG + M_STOK); float* slot_w = (float*)(BIG + M_SW); bf16_t* Hh = (bf16_t*)(BIG + M_H); bf16_t* YS = (bf16_t*)(BIG + M_YS); \
    (void)bid; (void)lane; (void)wid; (void)gw; (void)HB; (void)WB; (void)BIG; (void)Y32; (void)tabA; (void)tabB; (void)ctile; (void)blk_e; (void)nblk_p; (void)etot; (void)logits; (void)a_e; (void)a_g; (void)a_pos; (void)a_slot; (void)whist; (void)slot_tok; (void)slot_w; (void)Hh; (void)YS;

#pragma nounroll
    for (int layer = 0; layer < DEPTH; ++layer) {
        const int kind = layer % 3, slot = layer / 3;
        if (RUN) { RV
            if (layer == 0) {
                for (int i = bid * NTHREADS + tid; i < 16 * 2048; i += GRID * NTHREADS) { const int h = i >> 11, d = i & 2047; tabA[i] = p.rel_bias[t5_bucket(d) * 16 + h] * LOG2E; }
                for (int i = bid * NTHREADS + tid; i < 3 * 16 * 132; i += GRID * NTHREADS) { const int g = i / (16 * 132), h = (i / 132) % 16, d = i % 132; const int dil = (g == 0) ? 1 : (g == 1) ? 4 : 16;
                    tabB[i] = (d <= 128) ? p.rel_bias[t5_bucket(d * dil) * 16 + h] * LOG2E : 0.f; }
                for (long i = (long)bid * NTHREADS + tid; i < (long)T * DM / 8; i += (long)GRID * NTHREADS) { const f32x4 a = *(const f32x4*)(p.x + i * 8), b2 = *(const f32x4*)(p.x + i * 8 + 4);
                    u32x4 w; w.x = cvt_pk_bf16(a[0], a[1]); w.y = cvt_pk_bf16(a[2], a[3]); w.z = cvt_pk_bf16(b2[0], b2[1]); w.w = cvt_pk_bf16(b2[2], b2[3]); *(u32x4*)(HB + i * 8) = w; }
            }
            const size_t lw = (size_t)layer * 64 * 262144;
            cvt_run(p.moe_w_gate + lw, (bf16_t*)(WB + WB_GU), 1024, 256, 1024, 256, 64, 262144, 524288, 128, 256, 0, ctile, tid, bid);
            cvt_run(p.moe_w_up + lw, (bf16_t*)(WB + WB_GU), 1024, 256, 1024, 256, 64, 262144, 524288, 128, 256, 128, ctile, tid, bid);
            cvt_run(p.moe_w_down + lw, (bf16_t*)(WB + WB_D), 256, 1024, 256, 1024, 64, 262144, 262144, 1 << 30, 0, 0, ctile, tid, bid);
            cvt_run(p.moe_ws_gate + (size_t)layer * 262144, (bf16_t*)(WB + WB_GU) + (size_t)64 * 524288, 1024, 256, 1024, 256, 1, 0, 0, 128, 256, 0, ctile, tid, bid);
            cvt_run(p.moe_ws_up + (size_t)layer * 262144, (bf16_t*)(WB + WB_GU) + (size_t)64 * 524288, 1024, 256, 1024, 256, 1, 0, 0, 128, 256, 128, ctile, tid, bid);
            cvt_run(p.moe_ws_down + (size_t)layer * 262144, (bf16_t*)(WB + WB_D) + (size_t)64 * 262144, 256, 1024, 256, 1024, 1, 0, 0, 1 << 30, 0, 0, ctile, tid, bid);
            cvt_run(p.moe_w_router + (size_t)layer * 65536, (bf16_t*)(WB + WB_R), 1024, 64, 1024, 256, 1, 0, 0, 1 << 30, 0, 0, ctile, tid, bid);
            if (kind == 0) {
                cvt_run(p.a_w_in + (size_t)slot * 1024 * 2888, (bf16_t*)(WB + WB_MIX), 1024, 2888, 1024, 3072, 1, 0, 0, 1 << 30, 0, 0, ctile, tid, bid);
                cvt_run(p.a_w_o + (size_t)slot * 2048 * 1024, (bf16_t*)(WB + WB_MIX2), 2048, 1024, 2048, 1024, 1, 0, 0, 1 << 30, 0, 0, ctile, tid, bid);
            } else if (kind == 1) {
                cvt_run(p.b_w_in, (bf16_t*)(WB + WB_MIX), 1024, 9216, 1024, 9216, 1, 0, 0, 1 << 30, 0, 0, ctile, tid, bid);
                cvt_run(p.b_w_o, (bf16_t*)(WB + WB_MIX2), 1024, 1024, 1024, 1024, 1, 0, 0, 1 << 30, 0, 0, ctile, tid, bid);
            } else {
                cvt_run(p.c_w_in, (bf16_t*)(WB + WB_MIX), 1024, 416, 1024, 512, 1, 0, 0, 1 << 30, 0, 0, ctile, tid, bid);
                cvt_run(p.c_w_q_up, (bf16_t*)(WB + WB_MIX + 1048576), 256, 1536, 256, 1536, 1, 0, 0, 1 << 30, 0, 0, ctile, tid, bid);
                cvt_run(p.c_w_kv_up, (bf16_t*)(WB + WB_MIX + 2097152), 128, 2048, 256, 2048, 1, 0, 0, 1 << 30, 0, 0, ctile, tid, bid);
                cvt_run(p.c_w_o, (bf16_t*)(WB + WB_MIX2), 1024, 1024, 1024, 1024, 1, 0, 0, 1 << 30, 0, 0, ctile, tid, bid);
            }
        }
        SEAM();
        const int nrounds = (kind == 1) ? 3 : 1;
#pragma nounroll
        for (int rd = 0; rd < nrounds; ++rd) {
            if (RUN) { RV
                pg8::DenseSched S; pg8::EpiBf16 E;
                if (kind == 0) { S.init(HB, 1024, WB + WB_MIX, 1024, T, 3072, GRID, bid); E.O = (bf16_t*)(BIG + A_P); E.ldc = 3072; }
                else if (kind == 1) { S.init(HB, 1024, WB + WB_MIX + (size_t)rd * 3072 * 1024 * 2, 1024, T, 3072, GRID, bid); E.O = (bf16_t*)(BIG + B_P); E.ldc = 3072; }
                else { S.init(HB, 1024, WB + WB_MIX, 1024, T, 512, GRID, bid); E.O = (bf16_t*)(BIG + C_P); E.ldc = 512; }
                pg8::gemm_phase(lds + LDS_STAGE, S, E, 1024, tid);
            }
            SEAM();
            if (kind == 0) {
                if (RUN) { RV for (int it = gw; it < T / 4; it += NWAVES_TOTAL) { const int b = it % NBATCH, tq = (SEQ / 4 - 1 - it / NBATCH) * 4; score_wave((const bf16_t*)(BIG + A_P), (float*)(BIG + A_SC), b, tq, lane); } }
                SEAM();
                if (RUN) { RV for (int it = gw; it < T; it += NWAVES_TOTAL) { const int b = it % NBATCH, t = SEQ - 1 - it / NBATCH; select_wave((const float*)(BIG + A_SC), (unsigned*)(BIG + A_BM), b, t, lane); } }
                SEAM();
                if (RUN) { RV
                    const bf16_t* P = (const bf16_t*)(BIG + A_P); bf16_t* O = (bf16_t*)(BIG + A_O); const unsigned* BM = (const unsigned*)(BIG + A_BM);
                    LAS char* vl = (LAS char*)(lds + LDS_STAGE) + wid * 10240;
                    for (int it = gw; it < NBATCH * 64 * 16; it += NWAVES_TOTAL) { const int qb = 63 - (it / (NBATCH * 16)), rem = it % (NBATCH * 16), b = rem >> 4, h = rem & 15; const int t0 = qb * 32; const long row0 = (long)b * SEQ + t0;
                        FnDsa f; f.t0 = t0; f.sc = 0.08838834764831845f * LOG2E; f.tab = tabA + h * 2048; f.bm = BM + row0 * 64;
                        attn_wave32<128, 128>(P + row0 * 3072 + h * 128, 3072, P + (long)b * SEQ * 3072 + 2048, 3072, P + (long)b * SEQ * 3072 + 2176, 3072, 0, qb + 1, SEQ - 1, f, O + row0 * 2048 + h * 128, 2048, nullptr, 0, vl, lane); }
                }
                SEAM();
            } else if (kind == 1) {
                if (RUN) { RV
                    const int dil = (rd == 0) ? 1 : (rd == 1) ? 4 : 16; const int Ld = SEQ / dil; const int nqb = Ld / 32;
                    const bf16_t* P = (const bf16_t*)(BIG + B_P); bf16_t* Og = (bf16_t*)(BIG + B_OG) + (size_t)rd * T * 1024; float* lse = (float*)(BIG + B_LSE) + (size_t)rd * T * 16;
                    LAS char* vl = (LAS char*)(lds + LDS_STAGE) + wid * 10240;
                    for (int it = gw; it < NBATCH * 16 * 64; it += NWAVES_TOTAL) { const int b = it / (16 * 64), h = (it / 64) % 16, rq = it % 64, r = rq / nqb, qb = rq % nqb; const int i0 = qb * 32;
                        const long base = ((long)b * SEQ + r) * 3072 + h * 64; const long st = (long)dil * 3072;
                        FnDil f; f.i0 = i0; f.sc = 0.125f * LOG2E; f.tab = tabB + (rd * 16 + h) * 132;
                        int kt0 = (i0 - 128) / 32; kt0 = kt0 < 0 ? 0 : kt0;
                        const long orow = ((long)b * SEQ + r + (long)i0 * dil);
                        attn_wave32<64, 64>(P + base + (long)i0 * st, st, P + base + 1024, st, P + base + 2048, st, kt0, qb + 1, Ld - 1, f, Og + orow * 1024 + h * 64, (long)dil * 1024, lse + orow * 16 + h, (long)dil * 16, vl, lane); }
                }
                SEAM();
            } else {
                if (RUN) { RV prepc_phase((const bf16_t*)(BIG + C_P), p.c_q_norm, p.c_kv_norm, (bf16_t*)(BIG + C_AQ), (bf16_t*)(BIG + C_AKV), (bf16_t*)(BIG + C_KF), gw, lane); }
                SEAM();
                if (RUN) { RV
                    { pg8::DenseSched S; pg8::EpiBf16 E; S.init(BIG + C_AQ, 256, WB + WB_MIX + 1048576, 256, T, 1536, GRID, bid); E.O = (bf16_t*)(BIG + C_QF); E.ldc = 1536; pg8::gemm_phase(lds + LDS_STAGE, S, E, 256, tid); }
                }
                SEAM();
                if (RUN) { RV
                    { pg8::DenseSched S; pg8::EpiKV E; S.init(BIG + C_AKV, 256, WB + WB_MIX + 2097152, 256, T, 2048, GRID, bid); E.Kf = (bf16_t*)(BIG + C_KF); E.V = (bf16_t*)(BIG + C_V); pg8::gemm_phase(lds + LDS_STAGE, S, E, 256, tid); }
                }
                SEAM();
                if (RUN) { RV
                    const bf16_t* Qf = (const bf16_t*)(BIG + C_QF); const bf16_t* Kf = (const bf16_t*)(BIG + C_KF); const bf16_t* V = (const bf16_t*)(BIG + C_V); bf16_t* O = (bf16_t*)(BIG + C_O);
                    LAS char* vl = (LAS char*)(lds + LDS_STAGE) + wid * 10240;
                    for (int it = gw; it < NBATCH * 64 * 16; it += NWAVES_TOTAL) { const int qb = 63 - (it / (NBATCH * 16)), rem = it % (NBATCH * 16), b = rem >> 4, h = rem & 15; const int t0 = qb * 32; const long row0 = (long)b * SEQ + t0;
                        FnMLA f; f.t0 = t0; f.sc = 0.10206207261596575f * LOG2E;
                        attn_wave32<96, 64>(Qf + row0 * 1536 + h * 96, 1536, Kf + (long)b * SEQ * 1536 + h * 96, 1536, V + (long)b * SEQ * 1024 + h * 64, 1024, 0, qb + 1, SEQ - 1, f, O + row0 * 1024 + h * 64, 1024, nullptr, 0, vl, lane); }
                }
                SEAM();
            }
        }
        if (kind == 1) { if (RUN) { RV combine_phase((const bf16_t*)(BIG + B_OG), (const float*)(BIG + B_LSE), (bf16_t*)(BIG + B_O), tid, bid); } SEAM(); }
        if (RUN) { RV
            pg8::DenseSched S; pg8::EpiResid E; E.Hb = HB; E.Y = Y32;
            if (kind == 0) S.init(BIG + A_O, 2048, WB + WB_MIX2, 2048, T, 1024, GRID, bid);
            else if (kind == 1) S.init(BIG + B_O, 1024, WB + WB_MIX2, 1024, T, 1024, GRID, bid);
            else S.init(BIG + C_O, 1024, WB + WB_MIX2, 1024, T, 1024, GRID, bid);
            pg8::gemm_phase(lds + LDS_STAGE, S, E, (kind == 0) ? 2048 : 1024, tid);
        }
        SEAM();
        if (RUN) { RV ln1_phase(Y32, p.ln_g + (size_t)(layer * 2) * DM, p.ln_b + (size_t)(layer * 2) * DM, HB, gw, lane); }
        SEAM();
        if (RUN) { RV pg8::DenseSched S; pg8::EpiRouter E; S.init(HB, 1024, WB + WB_R, 1024, T, 256, GRID, bid); E.C = logits; pg8::gemm_phase(lds + LDS_STAGE, S, E, 1024, tid); }
        SEAM();
        if (RUN) { RV route_phase(logits, p.moe_bias + layer * 64, a_e, a_g, a_pos, whist, gw, lane); }
        SEAM();
        if (RUN) { RV assign_phase(whist, a_e, a_g, a_pos, a_slot, slot_tok, slot_w, etot, (LAS int*)(lds + LDS_STAGE), tid, bid); }
        SEAM();
        if (RUN) { RV
            const int nblk_r = build_blk_table(etot, blk_e, nblk_p, tid);
            pg8::MoeSched S; S.A = (const char*)HB; S.Bt = WB + WB_GU; S.lda = 1024; S.ldbv = 1024; S.b_estride = (size_t)512 * 1024 * 2; S.npn_shift = 1; S.nblk_r = nblk_r; S.G = GRID; S.c = bid; S.slot_tok = slot_tok; S.blk_e = blk_e; S.gather = true;
            pg8::EpiSwiglu E; E.H = Hh;
            pg8::gemm_phase(lds + LDS_STAGE, S, E, 1024, tid);
        }
        SEAM();
        if (RUN) { RV
            const int nblk_r = build_blk_table(etot, blk_e, nblk_p, tid);
            pg8::MoeSched S; S.A = (const char*)Hh; S.Bt = WB + WB_D; S.lda = 256; S.ldbv = 256; S.b_estride = (size_t)1024 * 256 * 2; S.npn_shift = 2; S.nblk_r = nblk_r; S.G = GRID; S.c = bid; S.slot_tok = slot_tok; S.blk_e = blk_e; S.gather = false;
            pg8::EpiDown E; E.YS = YS; E.slot_w = slot_w;
            pg8::gemm_phase(lds + LDS_STAGE, S, E, 256, tid);
        }
        SEAM();
        if (RUN) { RV ln2_phase(YS, a_slot, p.ln_g + (size_t)(layer * 2 + 1) * DM, p.ln_b + (size_t)(layer * 2 + 1) * DM, HB, (layer == DEPTH - 1) ? p.out : nullptr, gw, lane); }
        SEAM();
    }
#undef RUN
#undef SEAM
#undef RV
}

static int count_regions() {
    int n = 0;
    for (int layer = 0; layer < DEPTH; ++layer) { const int kind = layer % 3; n += 1; const int nr = (kind == 1) ? 3 : 1; for (int r = 0; r < nr; ++r) n += (kind == 0) ? 4 : (kind == 1) ? 2 : 5; if (kind == 1) n += 1; n += 2; n += 6; }
    return n;
}

extern "C" void kernel_launch(void* const* d_in, const int* in_sizes, int n_in, void* d_out, int out_size, void* d_ws, size_t ws_size, hipStream_t stream) {
    static int ready = 0;
    if (!ready) {
        if (n_in != 22 || out_size != T * DM || ws_size < WS_END) { fprintf(stderr, "kernel_launch: unexpected shapes (n_in %d out %d ws %zu need %zu)\n", n_in, out_size, ws_size, (size_t)WS_END); ready = -1; return; }
        int dev = 0, cus = 0, per_cu = 0;
        if (hipGetDevice(&dev) != hipSuccess || hipDeviceGetAttribute(&cus, hipDeviceAttributeMultiprocessorCount, dev) != hipSuccess) { ready = -1; return; }
        if (hipFuncSetAttribute((const void*)fwd, hipFuncAttributeMaxDynamicSharedMemorySize, LDS_BYTES) != hipSuccess) { fprintf(stderr, "kernel_launch: hipFuncSetAttribute failed\n"); ready = -1; return; }
        if (hipOccupancyMaxActiveBlocksPerMultiprocessor(&per_cu, (const void*)fwd, NTHREADS, LDS_BYTES) != hipSuccess || per_cu < 1) { fprintf(stderr, "kernel_launch: occupancy query says %d\n", per_cu); ready = -1; return; }
        if (cus < GRID) { fprintf(stderr, "kernel_launch: %d CUs < %d\n", cus, GRID); ready = -1; return; }
        ready = 1;
    }
    if (ready < 0) return;
    hipMemsetAsync((char*)d_ws + WS_CTL, 0, CTL_BYTES, stream);
    Params p{};
    const float** pp = (const float**)&p;
    for (int i = 0; i < 22; ++i) pp[i] = (const float*)d_in[i];
    p.out = (float*)d_out; p.ws = (char*)d_ws;
#if MULTI_LAUNCH
    const int nreg = count_regions();
    for (int r = 0; r < nreg; ++r) { p.lo = r; p.hi = r + 1; hipLaunchKernelGGL(fwd, dim3(GRID), dim3(NTHREADS), LDS_BYTES, stream, p); }
#else
    p.lo = 0; p.hi = 1 << 30;
    hipLaunchKernelGGL(fwd, dim3(GRID), dim3(NTHREADS), LDS_BYTES, stream, p);
#endif
}
```

```cpp
#include <hip/hip_runtime.h>
#include <cstdio>
#include <cstdint>

#ifndef DEBUG_CHECKS
#define DEBUG_CHECKS 0
#endif
#ifndef REPEAT_MASK
#define REPEAT_MASK 0
#endif
#define REP(bit) for (int rep_ = 0; rep_ < ((((REPEAT_MASK) >> (bit)) & 1) + 1); ++rep_)
#ifndef MULTI_LAUNCH
#define MULTI_LAUNCH 0
#endif

#define LAS __attribute__((address_space(3)))
typedef unsigned short bf16_t;
typedef short bf16x8 __attribute__((ext_vector_type(8)));
typedef short s16x4 __attribute__((ext_vector_type(4)));
typedef float f32x2 __attribute__((ext_vector_type(2)));
typedef float f32x4 __attribute__((ext_vector_type(4)));
typedef float f32x16 __attribute__((ext_vector_type(16)));
typedef unsigned u32x4 __attribute__((ext_vector_type(4)));
typedef unsigned u32x2 __attribute__((ext_vector_type(2)));

constexpr int T = 32768, DM = 1024, SEQ = 2048, NBATCH = 16, DEPTH = 4;
constexpr float DN_ALPHA = 1.6817928305074292f;
constexpr float LOG2E = 1.4426950408889634f;
constexpr float LN2F = 0.6931471805599453f;
constexpr float NEGF = -1.0e30f;
constexpr int NSLOT_R = 8 * T + 64 * 256, SH_SLOT0 = NSLOT_R, NSLOT = NSLOT_R + T;
constexpr int GRID = 256, NTHREADS = 512, NWAVES_TOTAL = GRID * 8;

constexpr size_t WS_CTL = 0;
constexpr size_t CTL_DIAG = 16384, CTL_ETOT = 32768, CTL_BYTES = 65536;
constexpr size_t WS_TABA = 65536;
constexpr size_t WS_TABB = WS_TABA + 131072;
constexpr size_t WS_HB = 262144;
constexpr size_t WS_WB = WS_HB + (size_t)T * DM * 2;
constexpr size_t WB_GU = 0, WB_D = 68157440, WB_R = 102236160, WB_MIX = 102760448, WB_MIX2 = WB_MIX + 18874368, WB_BYTES = 125829120;
constexpr size_t WS_BIG = WS_WB + WB_BYTES;
constexpr size_t BIG_Y32 = 408944640;
constexpr size_t A_P = 0, A_IDX = 201326592, A_O = 218103808, A_SC = 218103808;
constexpr size_t B_P = 0, B_O = 0, B_OG = 201326592, B_LSE = 402653184;
constexpr size_t C_P = 0, C_AQ = 33554432, C_AKV = 50331648, C_QF = 67108864, C_KF = 167772160, C_V = 268435456, C_O = 335544320;
constexpr size_t M_LOG = 0, M_AE = 8388608, M_AG = 9437184, M_APOS = 10485760, M_ASLOT = 11534336, M_WHIST = 12582912, M_STOK = 13107200, M_SW = 14352384, M_H = 16777216, M_YS = 176160768;
constexpr size_t BIG_BYTES = M_YS + (size_t)NSLOT * 1024 * 2;
constexpr float YS_SCALE = 64.0f, YS_INV = 1.0f / 64.0f;
constexpr size_t WS_END = WS_BIG + BIG_BYTES;

constexpr int LDS_STAGE = 0, LDS_BARW = 131072, LDS_BLK = 131072 + 64, LDS_NBLK = 131072 + 64 + 1280, LDS_TOKW = 135168, LDS_BYTES = 135168 + 12 * 2048;

__device__ __forceinline__ bf16_t f2bf(float f) { unsigned u = __float_as_uint(f); u += 0x7FFFu + ((u >> 16) & 1u); return (bf16_t)(u >> 16); }
__device__ __forceinline__ float bf2f(bf16_t b) { return __uint_as_float(((unsigned)b) << 16); }
__device__ __forceinline__ float bflo(unsigned w) { return __uint_as_float(w << 16); }
__device__ __forceinline__ float bfhi(unsigned w) { return __uint_as_float(w & 0xffff0000u); }
__device__ __forceinline__ unsigned cvt_pk_bf16(float lo, float hi) { unsigned r; asm volatile("v_cvt_pk_bf16_f32 %0, %1, %2" : "=v"(r) : "v"(lo), "v"(hi)); return r; }
__device__ __forceinline__ float swapmax(float v) { auto rr = __builtin_amdgcn_permlane32_swap(__float_as_uint(v), __float_as_uint(v), false, false); return fmaxf(__uint_as_float(rr[0]), __uint_as_float(rr[1])); }
__device__ __forceinline__ float swapadd2(float a, float b) { auto rr = __builtin_amdgcn_permlane32_swap(__float_as_uint(a), __float_as_uint(b), false, false); return __uint_as_float(rr[0]) + __uint_as_float(rr[1]); }
__device__ __forceinline__ int crow(int r, int hi) { return (r & 3) + 8 * (r >> 2) + 4 * hi; }
__device__ __forceinline__ void sincos_small(float x, float& sn, float& cs) {
    const float k = rintf(x * 0.6366197723675814f); const int q = (int)k;
    float r = fmaf(-k, 1.5707962512969971f, x); r = fmaf(-k, 7.549789415861596e-08f, r);
    const float z = r * r;
    const float sp = r + r * z * (-1.6666654611e-1f + z * (8.3321608736e-3f + z * (-1.9515295891e-4f)));
    const float cp = 1.0f - 0.5f * z + z * z * (4.166664568298827e-2f + z * (-1.388731625493765e-3f + z * 2.443315711809948e-5f));
    const float a = (q & 1) ? cp : sp, b = (q & 1) ? sp : cp;
    sn = (q & 2) ? -a : a; cs = ((q + 1) & 2) ? -b : b;
}
__device__ __forceinline__ float rope_inv_freq(int i) { return __builtin_amdgcn_exp2f(-(float)i * (13.287712379549449f / 16.0f)); }

#define XB_TMO      128
#define XB_XCNT(j)  (256  + 64 * (j))
#define XB_XSUB(j)  (1280 + 64 * (j))
#define XB_XGEN(j)  (2304 + 64 * (j))
#define XB_TOP      3328
#define XB_TOPGEN   3392
#define XCD_BAR_WORDS 3456
#define XB_SPIN_CAP (1u << 18)
__device__ __forceinline__ unsigned xb_ld(unsigned* p)              { return __hip_atomic_load(p, __ATOMIC_RELAXED, __HIP_MEMORY_SCOPE_AGENT); }
__device__ __forceinline__ unsigned xb_add(unsigned* p, unsigned v) { return __hip_atomic_fetch_add(p, v, __ATOMIC_RELAXED, __HIP_MEMORY_SCOPE_AGENT); }
__device__ __forceinline__ unsigned xb_xcc_id() { return (unsigned)__builtin_amdgcn_s_getreg((3 << 11) | 20) & 0xFu; }
#define XB_SPIN(cond, bar) do { unsigned _sp = 0; while (cond) { __builtin_amdgcn_s_sleep(1); \
    if ((++_sp & 255u) == 0u) { if (xb_ld(&(bar)[XB_TMO])) break; if (_sp > XB_SPIN_CAP) { atomicAdd(&(bar)[XB_TMO], 1u); break; } } } } while (0)
struct XcdBarrier { unsigned* bar; unsigned x; volatile LAS unsigned* st; int wid; };
__device__ __forceinline__ int lane_id() { return (int)__builtin_amdgcn_mbcnt_hi(~0u, __builtin_amdgcn_mbcnt_lo(~0u, 0u)); }
__device__ __forceinline__ XcdBarrier xcd_barrier_post(unsigned* bar, volatile LAS unsigned* st, int wid) {
    XcdBarrier b; b.bar = bar; b.x = xb_xcc_id(); b.st = st; b.wid = wid;
    if (wid == 0 && lane_id() == 0) (void)xb_add(&bar[XB_XCNT(b.x)], 1u);
    return b;
}
__device__ __forceinline__ void xcd_barrier_complete(unsigned* bar, unsigned x, unsigned& nloc, unsigned& nx) {
    const unsigned G = gridDim.x * gridDim.y * gridDim.z;
    unsigned sum, cnt, mine, sp = 0u;
    for (;;) {
        sum = 0u; cnt = 0u; mine = 0u;
#pragma unroll
        for (unsigned j = 0; j < 16; ++j) { const unsigned c = xb_ld(&bar[XB_XCNT(j)]); sum += c; cnt += (c > 0u) ? 1u : 0u; mine = (j == x) ? c : mine; }
        if (sum == G) break;
        __builtin_amdgcn_s_sleep(1);
        if ((++sp & 255u) == 0u) { if (xb_ld(&bar[XB_TMO])) break; if (sp > XB_SPIN_CAP) { atomicAdd(&bar[XB_TMO], 1u); break; } }
    }
    nloc = mine > 0u ? mine : 1u; nx = cnt > 0u ? cnt : 1u;
}
__device__ __forceinline__ void xcd_barrier(const XcdBarrier& b_) {
    asm volatile("s_waitcnt vmcnt(0)" ::: "memory");
    __syncthreads();
    XcdBarrier b = b_; asm volatile("" : "+s"(b.bar), "+s"(b.x));
    if (b.wid == 0 && lane_id() == 0) {
        unsigned* bar = b.bar;
        __builtin_amdgcn_s_waitcnt(0);
        unsigned nloc = b.st[0], nx = b.st[1];
        if (nloc == 0u) { xcd_barrier_complete(bar, b.x, nloc, nx); b.st[0] = nloc; b.st[1] = nx; }
        const unsigned old = xb_add(&bar[XB_XSUB(b.x)], 1u);
        const unsigned gen = old / nloc;
        if (old + 1u == (gen + 1u) * nloc) {
            __builtin_amdgcn_fence(__ATOMIC_RELEASE, "agent");
            asm volatile("s_waitcnt vmcnt(0)" ::: "memory");
            const unsigned og = xb_add(&bar[XB_TOP], 1u);
            const unsigned tg = og / nx;
            if (og + 1u == (tg + 1u) * nx) xb_add(&bar[XB_TOPGEN], 1u);
            else XB_SPIN(xb_ld(&bar[XB_TOPGEN]) == tg, bar);
            __builtin_amdgcn_fence(__ATOMIC_ACQUIRE, "agent");
            xb_add(&bar[XB_XGEN(b.x)], 1u);
            asm volatile("s_waitcnt vmcnt(0)" ::: "memory");
        } else {
            XB_SPIN(xb_ld(&bar[XB_XGEN(b.x)]) == gen, bar);
            __builtin_amdgcn_fence(__ATOMIC_ACQUIRE, "agent");
            asm volatile("s_waitcnt vmcnt(0)" ::: "memory");
        }
    }
    __syncthreads();
}

namespace pg8 {
constexpr int BM = 256, BK = 64, HALF = 128, HTB = HALF * BK * 2, STAGE_BYTES = 8 * HTB, NXCD = 8, WGM = 8;
__host__ __device__ __forceinline__ int lds_byte(int r, int c) { const int st = (r >> 4) * 2 + (c >> 5), rr = r & 15, cc = c & 31, ob = rr * 64 + cc * 2; return st * 1024 + (ob ^ (((ob >> 9) & 1) << 5)); }
__host__ __device__ __forceinline__ void stage_rc(int b, int& R, int& C) { const int st = b / 1024, sb = b % 1024, swz = sb ^ (((sb >> 9) & 1) << 5); R = (st >> 1) * 16 + swz / 64; C = (st & 1) * 32 + (swz % 64) / 2; }
__host__ __device__ __forceinline__ int perm32(int rho) { const int n = rho >> 4, i = rho & 15; return 8 * (i >> 2) + 4 * n + (i & 3); }

struct Unit { int pm, pn, e, slot0, ui; };

struct DenseSched {
    static constexpr bool UNIT_VOFF = false;
    const char* A; const char* Bt; int lda, ldbv; int nM, nN, nwg, G, c;
    __device__ __forceinline__ void init(const void* A_, int lda_, const void* Bt_, int ldb_, int M, int N, int G_, int c_) { A = (const char*)A_; Bt = (const char*)Bt_; lda = lda_; ldbv = ldb_; nM = M / BM; nN = N / BM; nwg = nM * nN; G = G_; c = c_; }
    __device__ __forceinline__ bool next(int i, Unit& u) const {
        const long L = (long)i * G + c; if (L >= nwg) return false;
        int wgid = (int)L; { const int q = nwg / NXCD, r = nwg % NXCD, xcd = wgid % NXCD, off = wgid / NXCD; wgid = (xcd < r ? xcd * (q + 1) : r * (q + 1) + (xcd - r) * q) + off; }
        const int nig = WGM * nN, gid = wgid / nig, fm = gid * WGM, gsz = (nM - fm) < WGM ? (nM - fm) : WGM;
        u.pm = fm + ((wgid % nig) % gsz); u.pn = (wgid % nig) / gsz; u.e = 0; u.slot0 = 0; u.ui = i; return true;
    }
    __device__ __forceinline__ const char* a_base(const Unit& u) const { return A + (size_t)u.pm * 256 * lda * 2; }
    __device__ __forceinline__ unsigned a_voff(const Unit&, int row, int col) const { return (unsigned)(row * lda + col) * 2u; }
    __device__ __forceinline__ size_t a_hstep() const { return (size_t)128 * lda * 2; }
    __device__ __forceinline__ const char* b_base(const Unit& u) const { return Bt + (size_t)u.pn * 256 * ldbv * 2; }
    __device__ __forceinline__ int ldb() const { return ldbv; }
};

template <bool GATHER> struct MoeSched {
    static constexpr bool UNIT_VOFF = GATHER; static constexpr bool gather = GATHER;
    const char* A; const char* Bt; int lda, ldbv; size_t b_estride; int npn_shift; int nblk_r; int G, c; const LAS int* tokw; const LAS unsigned char* blk_e;
    __device__ __forceinline__ bool next(int i, Unit& u) const {
        const long L = (long)i * G + c; const int blk = (int)(L >> npn_shift); if (blk >= nblk_r + 128) return false;
        u.pn = (int)(L & ((1 << npn_shift) - 1)); u.pm = blk; u.ui = i;
        if (blk < nblk_r) { u.e = blk_e[blk]; u.slot0 = blk * 256; } else { u.e = 64; u.slot0 = SH_SLOT0 + (blk - nblk_r) * 256; }
        return true;
    }
    __device__ __forceinline__ const char* a_base(const Unit& u) const { return gather ? A : A + (size_t)u.slot0 * lda * 2; }
    __device__ __forceinline__ unsigned a_voff(const Unit& u, int row, int col) const {
        if (gather) { const int tok = tokw[(u.ui * 256 + row) * 2]; return (unsigned)(tok * lda + col) * 2u; }
        return (unsigned)(row * lda + col) * 2u;
    }
    __device__ __forceinline__ size_t a_hstep() const { return GATHER ? (size_t)0 : (size_t)128 * lda * 2; }
    __device__ __forceinline__ const char* b_base(const Unit& u) const { return Bt + (size_t)u.e * b_estride + (size_t)u.pn * 256 * ldbv * 2; }
    __device__ __forceinline__ int ldb() const { return ldbv; }
};

struct EpiBf16 {
    static constexpr int PERMK = 1;
    bf16_t* O; int ldc;
    __device__ __forceinline__ void operator()(const f32x4 (&acc)[2][2][4][2], const Unit& u, int wr, int wc, int fr, int fq) const {
        const int row0 = u.pm * BM + wr * 64 + fr, col0 = u.pn * BM + wc * 32 + 8 * fq;
#pragma unroll
        for (int ai = 0; ai < 2; ++ai)
#pragma unroll
            for (int m = 0; m < 4; ++m) { bf16_t* rowp = O + (size_t)(row0 + ai * HALF + m * 16) * ldc + col0;
#pragma unroll
                for (int bj = 0; bj < 2; ++bj) { const f32x4 v0 = acc[ai][bj][m][0], v1 = acc[ai][bj][m][1];
                    u32x4 w; w.x = cvt_pk_bf16(v0[0], v0[1]); w.y = cvt_pk_bf16(v0[2], v0[3]); w.z = cvt_pk_bf16(v1[0], v1[1]); w.w = cvt_pk_bf16(v1[2], v1[3]);
                    *(u32x4*)(rowp + bj * HALF) = w; } }
    }
};
struct EpiKV {
    static constexpr int PERMK = 1;
    bf16_t* Kf; bf16_t* V;
    __device__ __forceinline__ void operator()(const f32x4 (&acc)[2][2][4][2], const Unit& u, int wr, int wc, int fr, int fq) const {
        const int row0 = u.pm * BM + wr * 64 + fr; const bool isK = wc < 2;
        bf16_t* Bp = isK ? Kf : V; const int pitch = isK ? 1536 : 1024, hw = isK ? 96 : 64; const int wi = (wc & 1) * 32 + 8 * fq;
#pragma unroll
        for (int ai = 0; ai < 2; ++ai)
#pragma unroll
            for (int m = 0; m < 4; ++m) { bf16_t* rowp = Bp + (size_t)(row0 + ai * HALF + m * 16) * pitch + (u.pn * 2) * hw + wi;
#pragma unroll
                for (int bj = 0; bj < 2; ++bj) { const f32x4 v0 = acc[ai][bj][m][0], v1 = acc[ai][bj][m][1];
                    u32x4 w; w.x = cvt_pk_bf16(v0[0], v0[1]); w.y = cvt_pk_bf16(v0[2], v0[3]); w.z = cvt_pk_bf16(v1[0], v1[1]); w.w = cvt_pk_bf16(v1[2], v1[3]);
                    *(u32x4*)(rowp + bj * hw) = w; } }
    }
};
struct EpiRouter {
    static constexpr int PERMK = 0;
    float* C;
    __device__ __forceinline__ void operator()(const f32x4 (&acc)[2][2][4][2], const Unit& u, int wr, int wc, int fr, int fq) const {
        if (u.pn != 0 || wc >= 2) return;
        const int row0 = u.pm * BM + wr * 64 + fr, col0 = wc * 32 + 4 * fq;
#pragma unroll
        for (int ai = 0; ai < 2; ++ai)
#pragma unroll
            for (int m = 0; m < 4; ++m) { float* rowp = C + (size_t)(row0 + ai * HALF + m * 16) * 64 + col0;
#pragma unroll
                for (int n = 0; n < 2; ++n) *(f32x4*)(rowp + n * 16) = acc[ai][0][m][n]; }
    }
};
struct EpiResid {
    static constexpr int PERMK = 0;
    const bf16_t* Hb; float* Y;
    __device__ __forceinline__ void operator()(const f32x4 (&acc)[2][2][4][2], const Unit& u, int wr, int wc, int fr, int fq) const {
        const int row0 = u.pm * BM + wr * 64 + fr, col0 = u.pn * BM + wc * 32 + 4 * fq;
#pragma unroll
        for (int ai = 0; ai < 2; ++ai)
#pragma unroll
            for (int m = 0; m < 4; ++m) { const size_t off = (size_t)(row0 + ai * HALF + m * 16) * DM + col0;
#pragma unroll
                for (int bj = 0; bj < 2; ++bj)
#pragma unroll
                    for (int n = 0; n < 2; ++n) { const u32x2 hb = *(const u32x2*)(Hb + off + bj * HALF + n * 16); const f32x4 a = acc[ai][bj][m][n];
                        f32x4 o; o[0] = DN_ALPHA * bflo(hb.x) + a[0]; o[1] = DN_ALPHA * bfhi(hb.x) + a[1]; o[2] = DN_ALPHA * bflo(hb.y) + a[2]; o[3] = DN_ALPHA * bfhi(hb.y) + a[3];
                        *(f32x4*)(Y + off + bj * HALF + n * 16) = o; } }
    }
};
__device__ __forceinline__ float silu_mul(float g, float u) { return g * __builtin_amdgcn_rcpf(1.0f + __builtin_amdgcn_exp2f(-g * LOG2E)) * u; }
struct EpiSwiglu {
    static constexpr int PERMK = 1;
    bf16_t* H; const LAS int* tokw;
    __device__ __forceinline__ void operator()(const f32x4 (&acc)[2][2][4][2], const Unit& u, int wr, int wc, int fr, int fq) const {
        const int rl0 = wr * 64 + fr, col0 = u.pn * 128 + wc * 32 + 8 * fq;
#pragma unroll
        for (int ai = 0; ai < 2; ++ai)
#pragma unroll
            for (int m = 0; m < 4; ++m) { const int rl = rl0 + ai * HALF + m * 16; const float w8 = __int_as_float(tokw[(u.ui * 256 + rl) * 2 + 1]); bf16_t* rowp = H + (size_t)(u.slot0 + rl) * 256 + col0;
                const f32x4 g0 = acc[ai][0][m][0], g1 = acc[ai][0][m][1], u0 = acc[ai][1][m][0] * w8, u1 = acc[ai][1][m][1] * w8;
                u32x4 w; w.x = cvt_pk_bf16(silu_mul(g0[0], u0[0]), silu_mul(g0[1], u0[1])); w.y = cvt_pk_bf16(silu_mul(g0[2], u0[2]), silu_mul(g0[3], u0[3]));
                w.z = cvt_pk_bf16(silu_mul(g1[0], u1[0]), silu_mul(g1[1], u1[1])); w.w = cvt_pk_bf16(silu_mul(g1[2], u1[2]), silu_mul(g1[3], u1[3]));
                *(u32x4*)rowp = w; }
    }
};
struct EpiDown {
    static constexpr int PERMK = 2;
    unsigned char* YS;
    __device__ __forceinline__ void operator()(const f32x4 (&acc)[2][2][4][2], const Unit& u, int wr, int wc, int fr, int fq) const {
        const int row0 = u.slot0 + wr * 64 + fr, col0 = u.pn * BM + wc * 64 + 16 * fq;
#pragma unroll
        for (int ai = 0; ai < 2; ++ai)
#pragma unroll
            for (int m = 0; m < 4; ++m) { unsigned char* rowp = YS + (size_t)(row0 + ai * HALF + m * 16) * 1024 + col0;
                u32x4 w;
#pragma unroll
                for (int bj = 0; bj < 2; ++bj)
#pragma unroll
                    for (int n = 0; n < 2; ++n) { const f32x4 v = acc[ai][bj][m][n]; int pk = __float_as_int(v[0]);     pk = __builtin_amdgcn_cvt_pk_fp8_f32(v[0], v[1], pk, false); pk = __builtin_amdgcn_cvt_pk_fp8_f32(v[2], v[3], pk, true); w[bj * 2 + n] = (unsigned)pk; }
                *(u32x4*)rowp = w; }
    }
};

template <class Epi, class Sched>
__device__ __forceinline__ void gemm_phase(LAS unsigned char* lds, const Sched& S, const Epi& E, const int K, const int tid_in) {
    int tid_o = tid_in; asm volatile("" : "+v"(tid_o));
    const int tid = tid_o, wid = __builtin_amdgcn_readfirstlane(tid >> 6), lane = tid & 63, wr = wid >> 2, wc = wid & 3, fr = lane & 15, fq = lane >> 4;
    const int nt = K / BK;
    const int ldb = S.ldb();
    int Rr[2], Cc[2]; unsigned voffB[2];
#pragma unroll
    for (int i = 0; i < 2; ++i) { int R, C; stage_rc(tid * 16 + i * 8192, R, C); Rr[i] = R; Cc[i] = C;
        if (Epi::PERMK == 2) { const int c0 = 64 * (R >> 5) + 16 * ((R >> 2) & 3) + 4 * ((R >> 4) & 1) + (R & 3); voffB[i] = (unsigned)(c0 * ldb + C) * 2u; }
        else { const int Rb = (Epi::PERMK == 1) ? ((R & ~31) + perm32(R & 31)) : R; voffB[i] = (unsigned)(Rb * ldb + C) * 2u; } }
    const size_t kstep = (size_t)(BK * 2);
    const size_t hstepB = (Epi::PERMK == 2) ? (size_t)8 * ldb * 2 : (size_t)HALF * ldb * 2;
#define PG8_VB1 voffB
    const unsigned ldsw = (unsigned)wid * 1024u;
    const int aoff = lds_byte(wr * 64 + fr, fq * 8), boff = lds_byte(wc * 32 + fr, fq * 8);
#define PG8_SA(b, h) (((b) * 2 + (h)) * HTB)
#define PG8_SB(b, h) ((4 + (b) * 2 + (h)) * HTB)
#define PG8_STAGE(bufoff, gbase, voff) do { _Pragma("unroll") for (int _i = 0; _i < 2; ++_i) \
        __builtin_amdgcn_global_load_lds((const unsigned*)((const char*)(gbase) + (voff)[_i]), (LAS unsigned*)(lds + (bufoff) + ldsw + _i * 8192), 16, 0, 0); } while (0)
#define PG8_LDA(dst, b, h) do { _Pragma("unroll") for (int m = 0; m < 4; ++m) _Pragma("unroll") for (int k = 0; k < 2; ++k) dst[m][k] = *(const LAS bf16x8*)(lds + PG8_SA(b, h) + aoff + m * 2048 + k * 1024); } while (0)
#define PG8_LDB(dst, b, h) do { _Pragma("unroll") for (int n = 0; n < 2; ++n) _Pragma("unroll") for (int k = 0; k < 2; ++k) dst[n][k] = *(const LAS bf16x8*)(lds + PG8_SB(b, h) + boff + n * 2048 + k * 1024); } while (0)
#define PG8_MMA(ai, bj, At, Bt) do { __builtin_amdgcn_s_setprio(1); _Pragma("unroll") for (int m = 0; m < 4; ++m) _Pragma("unroll") for (int n = 0; n < 2; ++n) _Pragma("unroll") for (int k = 0; k < 2; ++k) \
        acc[ai][bj][m][n] = __builtin_amdgcn_mfma_f32_16x16x32_bf16(Bt[n][k], At[m][k], acc[ai][bj][m][n], 0, 0, 0); __builtin_amdgcn_s_setprio(0); } while (0)
#define PG8_WAIT_V(n) asm volatile("s_waitcnt vmcnt(" #n ")" ::: "memory")
#define PG8_WAIT_L(n) asm volatile("s_waitcnt lgkmcnt(" #n ")" ::: "memory")
#define PG8_BAR __builtin_amdgcn_s_barrier()
#define PG8_SCHED __builtin_amdgcn_sched_barrier(0)
    Unit cur, nxt; int ui = 0;
    if (!S.next(0, cur)) return;
    f32x4 acc[2][2][4][2];
#pragma unroll
    for (int a = 0; a < 2; ++a)
#pragma unroll
        for (int b = 0; b < 2; ++b)
#pragma unroll
            for (int m = 0; m < 4; ++m)
#pragma unroll
                for (int n = 0; n < 2; ++n) acc[a][b][m][n] = (f32x4){0.f, 0.f, 0.f, 0.f};
    bf16x8 At[4][2], B0[2][2], B1[2][2];
    unsigned vAc0[2], vAc1[2];
#pragma unroll
    for (int i = 0; i < 2; ++i) { vAc0[i] = S.a_voff(cur, Rr[i], Cc[i]); vAc1[i] = Sched::UNIT_VOFF ? S.a_voff(cur, HALF + Rr[i], Cc[i]) : 0u; }
    const size_t hstepA = Sched::UNIT_VOFF ? (size_t)0 : S.a_hstep();
#define PG8_VA1 (Sched::UNIT_VOFF ? vAc1 : vAc0)
    const char* cA = S.a_base(cur); const char* cB = S.b_base(cur);
    PG8_STAGE(PG8_SB(0, 0), cB, voffB); PG8_STAGE(PG8_SA(0, 0), cA, vAc0); PG8_STAGE(PG8_SB(0, 1), cB + hstepB, PG8_VB1); PG8_STAGE(PG8_SA(0, 1), cA + hstepA, PG8_VA1);
    if (wr == 1) PG8_BAR;
    PG8_WAIT_V(4); PG8_BAR;
    PG8_STAGE(PG8_SB(1, 0), cB + kstep, voffB); PG8_STAGE(PG8_SA(1, 0), cA + kstep, vAc0); PG8_STAGE(PG8_SB(1, 1), cB + hstepB + kstep, PG8_VB1);
    PG8_WAIT_V(6); PG8_BAR;
    for (;;) {
        const bool has_next = S.next(ui + 1, nxt);
        const char* nA = cA; const char* nB = cB;
        if (has_next) { nA = S.a_base(nxt); nB = S.b_base(nxt); }
        for (int t = 0; t < nt; t += 2) {
            const bool last = (t == nt - 2);
            const char* a1 = cA + (size_t)(t + 1) * kstep;
            const char* a2 = last ? nA : cA + (size_t)(t + 2) * kstep; const char* b2 = last ? nB : cB + (size_t)(t + 2) * kstep;
            const char* a3 = a2 + kstep; const char* b3 = b2 + kstep;
            asm volatile("" : "+s"(a1), "+s"(a2), "+s"(a3), "+s"(b2), "+s"(b3));
            PG8_LDB(B0, 0, 0); PG8_SCHED; PG8_LDA(At, 0, 0); PG8_STAGE(PG8_SA(1, 1), a1 + hstepA, PG8_VA1);
            if (Sched::UNIT_VOFF) { if (last && has_next) {
#pragma unroll
                for (int i = 0; i < 2; ++i) { vAc0[i] = S.a_voff(nxt, Rr[i], Cc[i]); vAc1[i] = S.a_voff(nxt, HALF + Rr[i], Cc[i]); } } }
            PG8_WAIT_L(8); PG8_BAR; PG8_WAIT_L(0); PG8_MMA(0, 0, At, B0); PG8_BAR; PG8_SCHED;
            PG8_LDB(B1, 0, 1); PG8_STAGE(PG8_SB(0, 0), b2, voffB);
            PG8_BAR; PG8_WAIT_L(0); PG8_MMA(0, 1, At, B1); PG8_BAR;
            PG8_LDA(At, 0, 1); PG8_STAGE(PG8_SA(0, 0), a2, vAc0);
            PG8_BAR; PG8_WAIT_L(0); PG8_MMA(1, 0, At, B0); PG8_BAR; PG8_SCHED;
            PG8_STAGE(PG8_SB(0, 1), b2 + hstepB, PG8_VB1);
            PG8_WAIT_V(6); PG8_BAR; PG8_MMA(1, 1, At, B1); PG8_BAR;
            PG8_LDB(B0, 1, 0); PG8_SCHED; PG8_LDA(At, 1, 0); PG8_STAGE(PG8_SA(0, 1), a2 + hstepA, PG8_VA1);
            PG8_WAIT_L(8); PG8_BAR; PG8_WAIT_L(0); PG8_MMA(0, 0, At, B0); PG8_BAR; PG8_SCHED;
            PG8_LDB(B1, 1, 1); PG8_STAGE(PG8_SB(1, 0), b3, voffB);
            PG8_BAR; PG8_WAIT_L(0); PG8_MMA(0, 1, At, B1); PG8_BAR;
            PG8_LDA(At, 1, 1); PG8_STAGE(PG8_SA(1, 0), a3, vAc0);
            PG8_BAR; PG8_WAIT_L(0); PG8_MMA(1, 0, At, B0); PG8_BAR; PG8_SCHED;
            PG8_STAGE(PG8_SB(1, 1), b3 + hstepB, PG8_VB1);
            PG8_WAIT_V(6); PG8_BAR; PG8_MMA(1, 1, At, B1); PG8_BAR;
        }
        E(acc, cur, wr, wc, fr, fq);
        if (!has_next) break;
#pragma unroll
        for (int a = 0; a < 2; ++a)
#pragma unroll
            for (int b = 0; b < 2; ++b)
#pragma unroll
                for (int m = 0; m < 4; ++m)
#pragma unroll
                    for (int n = 0; n < 2; ++n) acc[a][b][m][n] = (f32x4){0.f, 0.f, 0.f, 0.f};
        cur = nxt; cA = nA; cB = nB; ++ui;
    }
    PG8_WAIT_V(0);
    if (wr == 0) PG8_BAR;
    PG8_BAR;
#undef PG8_SA
#undef PG8_VB1
#undef PG8_VA1
#undef PG8_SB
#undef PG8_STAGE
#undef PG8_LDA
#undef PG8_LDB
#undef PG8_MMA
#undef PG8_WAIT_V
#undef PG8_WAIT_L
#undef PG8_BAR
#undef PG8_SCHED
}
}

typedef short v4i16_t __attribute__((ext_vector_type(4)));
__device__ __forceinline__ s16x4 vtr(const LAS char* p) { return __builtin_bit_cast(s16x4, __builtin_amdgcn_ds_read_tr16_b64_v4i16((LAS v4i16_t*)p)); }

template <int DQK, int DV, class F>
__device__ __forceinline__ void attn_wave32(const bf16_t* __restrict__ Qp, long qs, const bf16_t* __restrict__ Kp, long ks, const bf16_t* __restrict__ Vp, long vs,
                                            int kt0, int kt1, int kmax, const F& f, bf16_t* Op, long os, float* lsep, long lses, LAS char* vl, int lane) {
    constexpr int NS = DQK / 16, NC = DV / 32, CH = DV / 8, VP = (DV == 64) ? 192 : 320, NLD = 32 * CH / 64;
    const int r32 = lane & 31, hi = lane >> 5;
    bf16x8 qf[NS];
#pragma unroll
    for (int s = 0; s < NS; ++s) qf[s] = *(const bf16x8*)(Qp + (long)r32 * qs + 16 * s + 8 * hi);
    f.fix_q(qf, r32, hi);
    f32x16 o[NC];
#pragma unroll
    for (int c = 0; c < NC; ++c)
#pragma unroll
        for (int r = 0; r < 16; ++r) o[c][r] = 0.f;
    float m_run = NEGF, l_run = 0.f;
    const int blk = (lane >> 4) & 1, q4 = (lane & 15) >> 2, p4 = lane & 3;
    const LAS char* vrd = vl + (4 * hi + q4) * VP + (16 * blk + 4 * p4) * 2;
    for (int kt = kt0; kt < kt1; ++kt) {
        const int k0 = kt * 32;
        int krow = k0 + r32; krow = krow > kmax ? kmax : krow;
        const bf16_t* kr = Kp + (long)krow * ks + 8 * hi;
        f32x16 acc;
#pragma unroll
        for (int r = 0; r < 16; ++r) acc[r] = 0.f;
#pragma unroll
        for (int s = 0; s < NS; ++s) { const bf16x8 kf = *(const bf16x8*)(kr + 16 * s); acc = __builtin_amdgcn_mfma_f32_32x32x16_bf16(kf, qf[s], acc, 0, 0, 0); }
#pragma unroll
        for (int i = 0; i < NLD; ++i) { const int idx = lane + 64 * i, row = idx / CH, ch = idx % CH; int vrow = k0 + row; vrow = vrow > kmax ? kmax : vrow;
            const u32x4 v = *(const u32x4*)(Vp + (long)vrow * vs + ch * 8); *(LAS u32x4*)(vl + row * VP + ch * 16) = v; }
        const unsigned ctx = f.tile_ctx(kt, r32);
        float s[16]; float mx = NEGF;
#pragma unroll
        for (int r = 0; r < 16; ++r) { s[r] = f.logit(acc[r], k0 + crow(r, hi), r32, ctx); mx = fmaxf(mx, s[r]); }
        mx = swapmax(mx);
        const float m_new = fmaxf(m_run, mx);
        const float alpha = __builtin_amdgcn_exp2f(m_run - m_new);
        float ls = 0.f;
#pragma unroll
        for (int r = 0; r < 16; ++r) { const float pv = (s[r] > -1.0e29f) ? __builtin_amdgcn_exp2f(s[r] - m_new) : 0.f; s[r] = pv; ls += pv; }
        l_run = l_run * alpha + ls; m_run = m_new;
#pragma unroll
        for (int c = 0; c < NC; ++c)
#pragma unroll
            for (int r = 0; r < 16; ++r) o[c][r] *= alpha;
        bf16x8 pb[2];
#pragma unroll
        for (int j = 0; j < 2; ++j) { u32x4 w; w.x = cvt_pk_bf16(s[8 * j + 0], s[8 * j + 1]); w.y = cvt_pk_bf16(s[8 * j + 2], s[8 * j + 3]); w.z = cvt_pk_bf16(s[8 * j + 4], s[8 * j + 5]); w.w = cvt_pk_bf16(s[8 * j + 6], s[8 * j + 7]); pb[j] = __builtin_bit_cast(bf16x8, w); }
#pragma unroll
        for (int c = 0; c < NC; ++c)
#pragma unroll
            for (int j = 0; j < 2; ++j) {
                const s16x4 lo = vtr(vrd + (16 * j) * VP + 64 * c), h4 = vtr(vrd + (16 * j + 8) * VP + 64 * c);
                const bf16x8 vf = (bf16x8){lo[0], lo[1], lo[2], lo[3], h4[0], h4[1], h4[2], h4[3]};
                o[c] = __builtin_amdgcn_mfma_f32_32x32x16_bf16(vf, pb[j], o[c], 0, 0, 0);
            }
    }
    const float l_tot = swapadd2(l_run, l_run);
    const float inv = 1.0f / l_tot;
    bf16_t* orow = Op + (long)r32 * os;
#pragma unroll
    for (int c = 0; c < NC; ++c)
#pragma unroll
        for (int g = 0; g < 4; ++g) { u32x2 w; w.x = cvt_pk_bf16(o[c][4 * g] * inv, o[c][4 * g + 1] * inv); w.y = cvt_pk_bf16(o[c][4 * g + 2] * inv, o[c][4 * g + 3] * inv);
            *(u32x2*)(orow + 32 * c + 8 * g + 4 * hi) = w; }
    if (lsep != nullptr && hi == 0) lsep[(long)r32 * lses] = (m_run + __builtin_amdgcn_logf(l_tot)) * LN2F;
}

struct FnMLA {
    int t0; float sc;
    __device__ __forceinline__ void fix_q(bf16x8 (&qf)[6], int r32, int hi) const {
        const float pos = (float)(t0 + r32);
#pragma unroll
        for (int j = 0; j < 8; ++j) { const int i = 8 * hi + j; const float ang = pos * rope_inv_freq(i); float sn, cs; sincos_small(ang, sn, cs);
            const float x1 = bf2f((bf16_t)qf[4][j]), x2 = bf2f((bf16_t)qf[5][j]); qf[4][j] = (short)f2bf(x1 * cs - x2 * sn); qf[5][j] = (short)f2bf(x1 * sn + x2 * cs); }
    }
    __device__ __forceinline__ unsigned tile_ctx(int, int) const { return 0u; }
    __device__ __forceinline__ float logit(float a, int key, int r32, unsigned) const { return (key <= t0 + r32) ? a * sc : NEGF; }
};
struct FnDil {
    int i0; float sc; const float* tab;
    template <int N> __device__ __forceinline__ void fix_q(bf16x8 (&)[N], int, int) const {}
    __device__ __forceinline__ unsigned tile_ctx(int, int) const { return 0u; }
    __device__ __forceinline__ float logit(float a, int key, int r32, unsigned) const { const int d = i0 + r32 - key; const bool ok = (d >= 0) && (d <= 128); const int dc = ok ? d : 0; return ok ? a * sc + tab[dc] : NEGF; }
};
struct FnDsa {
    int t0; float sc; const float* tab; const unsigned* bm;
    template <int N> __device__ __forceinline__ void fix_q(bf16x8 (&)[N], int, int) const {}
    __device__ __forceinline__ unsigned tile_ctx(int kt, int r32) const { return bm[(long)r32 * 64 + kt]; }
    __device__ __forceinline__ float logit(float a, int key, int r32, unsigned ctx) const { const int d = t0 + r32 - key; const bool ok = ((ctx >> (key & 31)) & 1u) != 0u && d >= 0; const int dc = ok ? d : 0; return ok ? a * sc + tab[dc] : NEGF; }
};

__device__ __forceinline__ unsigned halfsum32(unsigned v) { v += __shfl_xor(v, 16); v += __shfl_xor(v, 8); v += __shfl_xor(v, 4); v += __shfl_xor(v, 2); v += __shfl_xor(v, 1); return v; }
__device__ __forceinline__ unsigned ord_u32(float f) { const unsigned u = __float_as_uint(f); return (u & 0x80000000u) ? ~u : (u | 0x80000000u); }
__device__ __forceinline__ void score_wave(const bf16_t* __restrict__ P, float* __restrict__ scores, int b, int t0, int lane) {
    const int r32 = lane & 31, hi = lane >> 5;
    const long rowb = (long)b * SEQ;
    const bf16_t* qrow = P + (rowb + t0 + (r32 >> 3)) * 3072 + 2304 + (r32 & 7) * 64 + 8 * hi;
    bf16x8 qf[4];
#pragma unroll
    for (int s = 0; s < 4; ++s) qf[s] = *(const bf16x8*)(qrow + 16 * s);
    float w[16];
#pragma unroll
    for (int r = 0; r < 16; ++r) w[r] = bf2f(P[(rowb + t0 + (r >> 2)) * 3072 + 2880 + (r & 3) + 4 * hi]) * (0.125f * 0.35355339059327373f);
    const int tA = t0 + 2 * hi, tB = tA + 1;
    const int nkt = (t0 + 3) / 32 + 1;
    float* sAo = scores + (rowb + tA) * SEQ + r32; float* sBo = scores + (rowb + tB) * SEQ + r32;
    for (int kt = 0; kt < nkt; ++kt) {
        const bf16_t* kr = P + (rowb + kt * 32 + r32) * 3072 + 2816 + 8 * hi;
        f32x16 acc;
#pragma unroll
        for (int r = 0; r < 16; ++r) acc[r] = 0.f;
#pragma unroll
        for (int s = 0; s < 4; ++s) { const bf16x8 kf = *(const bf16x8*)(kr + 16 * s); acc = __builtin_amdgcn_mfma_f32_32x32x16_bf16(qf[s], kf, acc, 0, 0, 0); }
        float p[4];
#pragma unroll
        for (int q = 0; q < 4; ++q) { float a = 0.f;
#pragma unroll
            for (int i = 0; i < 4; ++i) a += w[4 * q + i] * fmaxf(acc[4 * q + i], 0.f);
            p[q] = a; }
        const float sA = swapadd2(p[0], p[2]), sB = swapadd2(p[1], p[3]);
        sAo[kt * 32] = sA; sBo[kt * 32] = sB;
    }
}
__device__ __forceinline__ void select_wave(const float* __restrict__ scores, unsigned short* __restrict__ idxg, int b, int t, int lane) {
    const long row = (long)b * SEQ + t;
    unsigned short* ix = idxg + row * 256;
    if (t < 256) { for (int j = lane; j <= t; j += 64) ix[j] = (unsigned short)j; return; }
    const float* sr = scores + row * SEQ;
    unsigned u[32];
#pragma unroll
    for (int j = 0; j < 32; ++j) { const int key = 64 * j + lane; float v = 0.f; if (64 * j <= t) v = sr[key]; u[j] = (key <= t) ? ord_u32(v) : 0u; }
    unsigned thr = 0u;
    for (int bit = 31; bit >= 0; --bit) {
        const unsigned c = thr | (1u << bit); int n = 0;
#pragma unroll
        for (int j = 0; j < 32; ++j) n += __popcll(__ballot(u[j] >= c));
        thr = (n >= 256) ? c : thr;
    }
    int g = 0;
#pragma unroll
    for (int j = 0; j < 32; ++j) g += __popcll(__ballot(u[j] > thr));
    const int need = 256 - g; int eq = 0, base = 0;
    const unsigned long long lt = (1ull << lane) - 1ull;
#pragma unroll
    for (int j = 0; j < 32; ++j) {
        const bool isEq = (u[j] == thr); const unsigned long long be = __ballot(isEq);
        const bool sel = (u[j] > thr) || (isEq && (eq + __popcll(be & lt) < need));
        eq += __popcll(be);
        const unsigned long long bs = __ballot(sel);
        if (sel) ix[base + __popcll(bs & lt)] = (unsigned short)(64 * j + lane);
        base += __popcll(bs);
    }
}

__device__ __forceinline__ void dsa_attn_wave(const bf16_t* __restrict__ P, const unsigned short* __restrict__ idxg, bf16_t* __restrict__ O, int b, int t, LAS char* vl, const LAS float* btab, int lane) {
    constexpr int VP = 288;
    const int hd = lane & 15, g = lane >> 4;
    const long rowb = (long)b * SEQ, row = rowb + t;
    const int cnt = (t + 1 < 256) ? (t + 1) : 256;
    LAS unsigned short* ixl = (LAS unsigned short*)(vl + 32 * VP);
    {
        const u32x2 raw = *(const u32x2*)(idxg + row * 256 + 4 * lane);
        u32x2 w; const int j = 4 * lane;
        w.x = ((j < cnt) ? (raw.x & 0xffffu) : 0u) | ((j + 1 < cnt) ? (raw.x & 0xffff0000u) : 0u);
        w.y = ((j + 2 < cnt) ? (raw.y & 0xffffu) : 0u) | ((j + 3 < cnt) ? (raw.y & 0xffff0000u) : 0u);
        *(LAS u32x2*)(ixl + 4 * lane) = w;
    }
    bf16x8 qf[4];
#pragma unroll
    for (int s = 0; s < 4; ++s) qf[s] = *(const bf16x8*)(P + row * 3072 + hd * 128 + 32 * s + 8 * g);
    const bf16_t* Kb = P + rowb * 3072 + 2048 + 8 * g; const bf16_t* Vb = P + rowb * 3072 + 2176 + (lane & 3) * 8;
    f32x4 sT[16];
    bf16x8 kfa[8], kfb[8];
#define DSA_LOADK(dst, c) do { _Pragma("unroll") for (int tt = 0; tt < 2; ++tt) { const int kidx = ixl[16 * (2 * (c) + tt) + hd]; const bf16_t* kr = Kb + (long)kidx * 3072; \
        _Pragma("unroll") for (int s = 0; s < 4; ++s) dst[tt * 4 + s] = *(const bf16x8*)(kr + 32 * s); } } while (0)
#define DSA_MMAK(src, c) do { _Pragma("unroll") for (int tt = 0; tt < 2; ++tt) { f32x4 acc = (f32x4){0.f, 0.f, 0.f, 0.f}; \
        _Pragma("unroll") for (int s = 0; s < 4; ++s) acc = __builtin_amdgcn_mfma_f32_16x16x32_bf16(src[tt * 4 + s], qf[s], acc, 0, 0, 0); sT[2 * (c) + tt] = acc; } } while (0)
    DSA_LOADK(kfa, 0); DSA_LOADK(kfb, 1);
    DSA_MMAK(kfa, 0); DSA_LOADK(kfa, 2); DSA_MMAK(kfb, 1); DSA_LOADK(kfb, 3); DSA_MMAK(kfa, 2); DSA_LOADK(kfa, 4); DSA_MMAK(kfb, 3); DSA_LOADK(kfb, 5);
    DSA_MMAK(kfa, 4); DSA_LOADK(kfa, 6); DSA_MMAK(kfb, 5); DSA_LOADK(kfb, 7); DSA_MMAK(kfa, 6); DSA_MMAK(kfb, 7);
#undef DSA_LOADK
#undef DSA_MMAK
    const int vr = lane >> 2;
    u32x4 vv[8];
#define DSA_LOADV(m) do { const int k0 = ixl[32 * (m) + vr], k1 = ixl[32 * (m) + 16 + vr]; const bf16_t* v0 = Vb + (long)k0 * 3072; const bf16_t* v1 = Vb + (long)k1 * 3072; \
        _Pragma("unroll") for (int i = 0; i < 8; ++i) vv[i] = *(const u32x4*)(((i & 1) ? v1 : v0) + (i >> 1) * 32); } while (0)
    DSA_LOADV(0);
    const float sc = 0.08838834764831845f * LOG2E;
    float mx = NEGF;
#pragma unroll
    for (int tau = 0; tau < 16; ++tau) {
        const int j0 = 16 * tau + 4 * g;
        const u32x2 kw = *(const LAS u32x2*)(ixl + j0);
#pragma unroll
        for (int i = 0; i < 4; ++i) {
            const int key = (int)((i < 2 ? kw.x : kw.y) >> (16 * (i & 1))) & 0xffff;
            const bool ok = (j0 + i) < cnt;
            const int dist = ok ? (t - key) : 0;
            int bk = 16 + (int)((__builtin_amdgcn_logf((float)dist) - 4.0f) * (16.0f / 7.0f)); bk = bk > 31 ? 31 : bk; bk = dist < 16 ? dist : bk;
            const float lg = ok ? (sT[tau][i] * sc + btab[bk * 16 + hd]) : NEGF;
            sT[tau][i] = lg; mx = fmaxf(mx, lg);
        }
    }
    mx = fmaxf(mx, __shfl_xor(mx, 16)); mx = fmaxf(mx, __shfl_xor(mx, 32));
    float ls = 0.f;
#pragma unroll
    for (int tau = 0; tau < 16; ++tau)
#pragma unroll
        for (int i = 0; i < 4; ++i) { const float pv = (sT[tau][i] > -1.0e29f) ? __builtin_amdgcn_exp2f(sT[tau][i] - mx) : 0.f; sT[tau][i] = pv; ls += pv; }
    ls += __shfl_xor(ls, 16); ls += __shfl_xor(ls, 32);
    const float inv = 1.0f / ls;
    f32x4 o[8];
#pragma unroll
    for (int c = 0; c < 8; ++c) o[c] = (f32x4){0.f, 0.f, 0.f, 0.f};
    const int q4 = (lane & 15) >> 2, p4 = lane & 3;
    const LAS char* vrd = vl + (4 * g + q4) * VP + 8 * p4;
    LAS char* vwr = vl + vr * VP + (lane & 3) * 16;
#pragma unroll
    for (int m = 0; m < 8; ++m) {
#pragma unroll
        for (int i = 0; i < 8; ++i) *(LAS u32x4*)(vwr + (i & 1) * 16 * VP + (i >> 1) * 64) = vv[i];
        if (m + 1 < 8) DSA_LOADV(m + 1);
        u32x4 w; w.x = cvt_pk_bf16(sT[2 * m][0], sT[2 * m][1]); w.y = cvt_pk_bf16(sT[2 * m][2], sT[2 * m][3]); w.z = cvt_pk_bf16(sT[2 * m + 1][0], sT[2 * m + 1][1]); w.w = cvt_pk_bf16(sT[2 * m + 1][2], sT[2 * m + 1][3]);
        const bf16x8 pb = __builtin_bit_cast(bf16x8, w);
#pragma unroll
        for (int c = 0; c < 8; ++c) {
            const s16x4 lo = vtr(vrd + 32 * c), h4 = vtr(vrd + 16 * VP + 32 * c);
            const bf16x8 vf = (bf16x8){lo[0], lo[1], lo[2], lo[3], h4[0], h4[1], h4[2], h4[3]};
            o[c] = __builtin_amdgcn_mfma_f32_16x16x32_bf16(vf, pb, o[c], 0, 0, 0);
        }
    }
#undef DSA_LOADV
    bf16_t* orow = O + row * 2048 + hd * 128 + 4 * g;
#pragma unroll
    for (int c = 0; c < 8; ++c) { u32x2 w; w.x = cvt_pk_bf16(o[c][0] * inv, o[c][1] * inv); w.y = cvt_pk_bf16(o[c][2] * inv, o[c][3] * inv); *(u32x2*)(orow + 16 * c) = w; }
}

__device__ __forceinline__ int t5_bucket(int dist) {
    if (dist < 16) return dist;
    const float df = (float)dist;
    int large = 16 + (int)((__builtin_amdgcn_logf(df) - 4.0f) * (16.0f / 7.0f));
    return large < 31 ? large : 31;
}

__device__ __forceinline__ void cvt_run(const float* __restrict__ src, bf16_t* __restrict__ dst, int K, int N, int Kout, int Nloop, int nb, size_t sbs, size_t dbs, int rchunk, int rstride, int rbase, LAS float* tile, const int tid, const int bid) {
    const int tk = Kout / 64, tn = Nloop / 64, per = tk * tn; const long total = (long)per * nb;
    for (long tix = bid; tix < total; tix += GRID) {
        const int b = (int)(tix / per), r = (int)(tix % per), kt = r % tk, ntile = r / tk, k0 = kt * 64, n0 = ntile * 64;
#pragma unroll
        for (int pass = 0; pass < 2; ++pass) { const int kk = pass * 32 + (tid >> 4), nn = (tid & 15) * 4, k = k0 + kk, n = n0 + nn;
            f32x4 v = (f32x4){0.f, 0.f, 0.f, 0.f}; if (k < K && n < N) v = *(const f32x4*)(src + (size_t)b * sbs + (size_t)k * N + n);
            tile[kk * 65 + nn] = v[0]; tile[kk * 65 + nn + 1] = v[1]; tile[kk * 65 + nn + 2] = v[2]; tile[kk * 65 + nn + 3] = v[3]; }
        __syncthreads();
        { const int nn = tid >> 3, kk8 = (tid & 7) * 8, n = n0 + nn; const int row = rbase + (n / rchunk) * rstride + (n % rchunk);
            u32x4 w; w.x = cvt_pk_bf16(tile[(kk8 + 0) * 65 + nn], tile[(kk8 + 1) * 65 + nn]); w.y = cvt_pk_bf16(tile[(kk8 + 2) * 65 + nn], tile[(kk8 + 3) * 65 + nn]);
            w.z = cvt_pk_bf16(tile[(kk8 + 4) * 65 + nn], tile[(kk8 + 5) * 65 + nn]); w.w = cvt_pk_bf16(tile[(kk8 + 6) * 65 + nn], tile[(kk8 + 7) * 65 + nn]);
            *(u32x4*)(dst + (size_t)b * dbs + (size_t)row * Kout + k0 + kk8) = w; }
        __syncthreads();
    }
}

__device__ __forceinline__ void ln1_phase(const float* __restrict__ Y, const float* __restrict__ g, const float* __restrict__ bta, bf16_t* __restrict__ HB, int gw, int lane) {
    f32x4 gv[4], bv[4];
#pragma unroll
    for (int j = 0; j < 4; ++j) { gv[j] = *(const f32x4*)(g + j * 256 + lane * 4); bv[j] = *(const f32x4*)(bta + j * 256 + lane * 4); }
    for (int row = gw; row < T; row += NWAVES_TOTAL) {
        f32x4 x[4]; float s = 0.f;
#pragma unroll
        for (int j = 0; j < 4; ++j) { x[j] = *(const f32x4*)(Y + (size_t)row * DM + j * 256 + lane * 4); s += (x[j][0] + x[j][1]) + (x[j][2] + x[j][3]); }
#pragma unroll
        for (int o = 32; o >= 1; o >>= 1) s += __shfl_xor(s, o);
        const float mu = s * (1.0f / 1024.0f); float q = 0.f;
#pragma unroll
        for (int j = 0; j < 4; ++j) { x[j] = x[j] - mu; q += (x[j][0] * x[j][0] + x[j][1] * x[j][1]) + (x[j][2] * x[j][2] + x[j][3] * x[j][3]); }
#pragma unroll
        for (int o = 32; o >= 1; o >>= 1) q += __shfl_xor(q, o);
        const float rstd = rsqrtf(q * (1.0f / 1024.0f) + 1e-5f);
#pragma unroll
        for (int j = 0; j < 4; ++j) { const f32x4 y = x[j] * rstd * gv[j] + bv[j]; u32x2 w; w.x = cvt_pk_bf16(y[0], y[1]); w.y = cvt_pk_bf16(y[2], y[3]); *(u32x2*)(HB + (size_t)row * DM + j * 256 + lane * 4) = w; }
    }
}
__device__ __forceinline__ void ln2_phase(const unsigned char* __restrict__ YS, const int* __restrict__ a_slot, const float* __restrict__ g, const float* __restrict__ bta, bf16_t* HB, float* outp, int gw, int lane) {
    f32x4 gv[4], bv[4];
#pragma unroll
    for (int j = 0; j < 4; ++j) { gv[j] = *(const f32x4*)(g + lane * 16 + j * 4); bv[j] = *(const f32x4*)(bta + lane * 16 + j * 4); }
    for (int row = gw; row < T; row += NWAVES_TOTAL) {
        f32x4 x[4], y[4]; float s = 0.f;
        { const u32x4 h0 = *(const u32x4*)(HB + (size_t)row * DM + lane * 16), h1 = *(const u32x4*)(HB + (size_t)row * DM + lane * 16 + 8);
#pragma unroll
            for (int j = 0; j < 2; ++j) { x[j][0] = DN_ALPHA * bflo(h0[2 * j]); x[j][1] = DN_ALPHA * bfhi(h0[2 * j]); x[j][2] = DN_ALPHA * bflo(h0[2 * j + 1]); x[j][3] = DN_ALPHA * bfhi(h0[2 * j + 1]);
                x[2 + j][0] = DN_ALPHA * bflo(h1[2 * j]); x[2 + j][1] = DN_ALPHA * bfhi(h1[2 * j]); x[2 + j][2] = DN_ALPHA * bflo(h1[2 * j + 1]); x[2 + j][3] = DN_ALPHA * bfhi(h1[2 * j + 1]); } }
#pragma unroll
        for (int j = 0; j < 4; ++j) y[j] = (f32x4){0.f, 0.f, 0.f, 0.f};
        int sl[9];
#pragma unroll
        for (int k = 0; k < 8; ++k) sl[k] = a_slot[row * 8 + k];
        sl[8] = SH_SLOT0 + row;
        u32x4 yv[9];
#pragma unroll
        for (int k = 0; k < 9; ++k) yv[k] = *(const u32x4*)(YS + (size_t)sl[k] * 1024 + lane * 16);
#pragma unroll
        for (int k = 0; k < 9; ++k)
#pragma unroll
            for (int j = 0; j < 4; ++j) { const auto lo = __builtin_amdgcn_cvt_pk_f32_fp8((int)yv[k][j], false); const auto hi = __builtin_amdgcn_cvt_pk_f32_fp8((int)yv[k][j], true); y[j][0] += lo[0]; y[j][1] += lo[1]; y[j][2] += hi[0]; y[j][3] += hi[1]; }
#pragma unroll
        for (int j = 0; j < 4; ++j) { x[j] = x[j] + y[j] * YS_INV; s += (x[j][0] + x[j][1]) + (x[j][2] + x[j][3]); }
#pragma unroll
        for (int o = 32; o >= 1; o >>= 1) s += __shfl_xor(s, o);
        const float mu = s * (1.0f / 1024.0f); float q = 0.f;
#pragma unroll
        for (int j = 0; j < 4; ++j) { x[j] = x[j] - mu; q += (x[j][0] * x[j][0] + x[j][1] * x[j][1]) + (x[j][2] * x[j][2] + x[j][3] * x[j][3]); }
#pragma unroll
        for (int o = 32; o >= 1; o >>= 1) q += __shfl_xor(q, o);
        const float rstd = rsqrtf(q * (1.0f / 1024.0f) + 1e-5f);
        f32x4 r[4];
#pragma unroll
        for (int j = 0; j < 4; ++j) r[j] = x[j] * rstd * gv[j] + bv[j];
        if (outp != nullptr) {
#pragma unroll
            for (int j = 0; j < 4; ++j) *(f32x4*)(outp + (size_t)row * DM + lane * 16 + j * 4) = r[j];
        } else { u32x4 w0, w1; w0.x = cvt_pk_bf16(r[0][0], r[0][1]); w0.y = cvt_pk_bf16(r[0][2], r[0][3]); w0.z = cvt_pk_bf16(r[1][0], r[1][1]); w0.w = cvt_pk_bf16(r[1][2], r[1][3]);
            w1.x = cvt_pk_bf16(r[2][0], r[2][1]); w1.y = cvt_pk_bf16(r[2][2], r[2][3]); w1.z = cvt_pk_bf16(r[3][0], r[3][1]); w1.w = cvt_pk_bf16(r[3][2], r[3][3]);
            *(u32x4*)(HB + (size_t)row * DM + lane * 16) = w0; *(u32x4*)(HB + (size_t)row * DM + lane * 16 + 8) = w1; }
    }
}

__device__ __forceinline__ void route_phase(const float* __restrict__ logits, const float* __restrict__ ebias, int* __restrict__ a_e, float* __restrict__ a_g, int* __restrict__ a_pos, int* __restrict__ whist, int gw, int lane) {
    const float eb = ebias[lane];
    int mycnt = 0;
    for (int i = 0; i < 16; ++i) {
        const int t = gw * 16 + i;
        const float lg = logits[(size_t)t * 64 + lane];
        const float sg = 1.0f / (1.0f + __builtin_amdgcn_exp2f(-lg * LOG2E));
        const float c = sg + eb;
        float m1 = c; m1 = fmaxf(m1, __shfl_xor(m1, 1)); m1 = fmaxf(m1, __shfl_xor(m1, 2)); m1 = fmaxf(m1, __shfl_xor(m1, 4));
        int i1 = (c == m1) ? lane : 999; i1 = min(i1, __shfl_xor(i1, 1)); i1 = min(i1, __shfl_xor(i1, 2)); i1 = min(i1, __shfl_xor(i1, 4));
        float m2 = (lane == i1) ? -INFINITY : c; m2 = fmaxf(m2, __shfl_xor(m2, 1)); m2 = fmaxf(m2, __shfl_xor(m2, 2)); m2 = fmaxf(m2, __shfl_xor(m2, 4));
        const float gs = m1 + m2; const int myg = lane >> 3;
        int grank = 0;
#pragma unroll
        for (int g2 = 0; g2 < 8; ++g2) { const float v = __shfl(gs, g2 * 8); grank += (v > gs || (v == gs && g2 < myg)) ? 1 : 0; }
        const float cm = (grank < 4) ? c : -INFINITY;
        int rank = 0;
        for (int l2 = 0; l2 < 64; ++l2) { const float v = __shfl(cm, l2); rank += (v > cm || (v == cm && l2 < lane)) ? 1 : 0; }
        const bool sel = rank < 8;
        float ssum = sel ? sg : 0.f;
#pragma unroll
        for (int o = 32; o >= 1; o >>= 1) ssum += __shfl_xor(ssum, o);
        if (sel) { a_e[t * 8 + rank] = lane; a_g[t * 8 + rank] = sg / ssum * 2.5f; a_pos[t * 8 + rank] = mycnt; mycnt += 1; }
    }
    whist[gw * 64 + lane] = mycnt;
}

__device__ __forceinline__ void assign_phase(const int* __restrict__ whist, const int* __restrict__ a_e, const float* __restrict__ a_g, const int* __restrict__ a_pos, int* __restrict__ a_slot,
                                             int* __restrict__ slot_tok, float* __restrict__ slot_w, int* __restrict__ etot, LAS int* L, const int tid, const int bid) {
    LAS int* red = L; LAS int* red2 = L + 512; LAS int* tot = L + 1024; LAS int* pre = L + 1088; LAS int* pstart = L + 1152; LAS int* base = L + 1216;
    const int e = tid & 63, part = tid >> 6; const int gw0 = bid * 8;
    int s = 0, s2 = 0;
    for (int w = part * 256; w < part * 256 + 256; ++w) { const int v = whist[w * 64 + e]; s += v; s2 += (w < gw0) ? v : 0; }
    red[part * 64 + e] = s; red2[part * 64 + e] = s2;
    __syncthreads();
    if (tid < 64) { int a = 0, b2 = 0;
#pragma unroll
        for (int p2 = 0; p2 < 8; ++p2) { a += red[p2 * 64 + tid]; b2 += red2[p2 * 64 + tid]; }
        tot[tid] = a; pre[tid] = b2;
        const int padded = ((a + 255) >> 8) << 8; int inc = padded;
#pragma unroll
        for (int o = 1; o < 64; o <<= 1) { const int v = __shfl_up(inc, o); if (tid >= o) inc += v; }
        pstart[tid] = inc - padded;
        int run = b2;
        for (int w = 0; w < 8; ++w) { base[w * 64 + tid] = run; run += whist[(gw0 + w) * 64 + tid]; }
        if (bid == 0) etot[tid] = a;
    }
    __syncthreads();
    for (int idx = tid; idx < 1024; idx += NTHREADS) { const int tl = idx >> 3; const int t = bid * 128 + tl; const int ee = a_e[t * 8 + (idx & 7)];
        const int slot = pstart[ee] + base[(tl >> 4) * 64 + ee] + a_pos[t * 8 + (idx & 7)];
        a_slot[t * 8 + (idx & 7)] = slot; slot_tok[slot] = t; slot_w[slot] = a_g[t * 8 + (idx & 7)]; }
    if (bid < 64) { const int ee = bid; const int a = tot[ee], padded = ((a + 255) >> 8) << 8;
        for (int i = a + tid; i < padded; i += NTHREADS) { slot_tok[pstart[ee] + i] = -1; slot_w[pstart[ee] + i] = 0.f; } }
    __syncthreads();
}
__device__ __forceinline__ int build_blk_table(const int* __restrict__ etot, LAS unsigned char* blk_e, LAS int* nblk_p, const int tid) {
    __syncthreads();
    if (tid < 64) { const int nbk = (etot[tid] + 255) >> 8; int inc = nbk;
#pragma unroll
        for (int o = 1; o < 64; o <<= 1) { const int v = __shfl_up(inc, o); if (tid >= o) inc += v; }
        const int st = inc - nbk; for (int i = 0; i < nbk; ++i) blk_e[st + i] = (unsigned char)tid;
        if (tid == 63) *nblk_p = inc; }
    __syncthreads();
    return *nblk_p;
}

__device__ __forceinline__ void prepc_phase(const bf16_t* __restrict__ Pc, const float* __restrict__ qn, const float* __restrict__ kvn, bf16_t* __restrict__ Aq, bf16_t* __restrict__ Akv, bf16_t* __restrict__ Kf, int gw, int lane) {
    const f32x4 gq = *(const f32x4*)(qn + lane * 4); const f32x2 gk = *(const f32x2*)(kvn + lane * 2);
    for (int t = gw; t < T; t += NWAVES_TOTAL) {
        const bf16_t* pr = Pc + (size_t)t * 512;
        const u32x2 cq = *(const u32x2*)(pr + lane * 4); const unsigned ck = *(const unsigned*)(pr + 256 + lane * 2);
        float x0 = bflo(cq.x), x1 = bfhi(cq.x), x2 = bflo(cq.y), x3 = bfhi(cq.y); float sq = x0 * x0 + x1 * x1 + x2 * x2 + x3 * x3;
        float y0 = bflo(ck), y1 = bfhi(ck); float sk = y0 * y0 + y1 * y1;
#pragma unroll
        for (int o = 32; o >= 1; o >>= 1) { sq += __shfl_xor(sq, o); sk += __shfl_xor(sk, o); }
        const float rq = rsqrtf(sq * (1.0f / 256.0f) + 1e-6f), rk = rsqrtf(sk * (1.0f / 128.0f) + 1e-6f);
        u32x2 wq; wq.x = cvt_pk_bf16(x0 * rq * gq[0], x1 * rq * gq[1]); wq.y = cvt_pk_bf16(x2 * rq * gq[2], x3 * rq * gq[3]);
        *(u32x2*)(Aq + (size_t)t * 256 + lane * 4) = wq;
        *(unsigned*)(Akv + (size_t)t * 256 + lane * 2) = cvt_pk_bf16(y0 * rk * gk[0], y1 * rk * gk[1]);
        *(unsigned*)(Akv + (size_t)t * 256 + 128 + lane * 2) = 0u;
        const int h = lane >> 2, qd = lane & 3; const float pos = (float)(t & (SEQ - 1));
        const u32x2 ka = *(const u32x2*)(pr + 384 + 4 * qd), kb = *(const u32x2*)(pr + 400 + 4 * qd);
        const float a[4] = {bflo(ka.x), bfhi(ka.x), bflo(ka.y), bfhi(ka.y)}, bb[4] = {bflo(kb.x), bfhi(kb.x), bflo(kb.y), bfhi(kb.y)};
        float o1[4], o2[4];
#pragma unroll
        for (int j = 0; j < 4; ++j) { const int i = 4 * qd + j; float sn, cs; sincos_small(pos * rope_inv_freq(i), sn, cs); o1[j] = a[j] * cs - bb[j] * sn; o2[j] = a[j] * sn + bb[j] * cs; }
        u32x2 w1, w2; w1.x = cvt_pk_bf16(o1[0], o1[1]); w1.y = cvt_pk_bf16(o1[2], o1[3]); w2.x = cvt_pk_bf16(o2[0], o2[1]); w2.y = cvt_pk_bf16(o2[2], o2[3]);
        *(u32x2*)(Kf + (size_t)t * 1536 + h * 96 + 64 + 4 * qd) = w1; *(u32x2*)(Kf + (size_t)t * 1536 + h * 96 + 80 + 4 * qd) = w2;
    }
}
__device__ __forceinline__ void combine_phase(const bf16_t* __restrict__ Og, const float* __restrict__ lse, bf16_t* __restrict__ O, const int tid, const int bid) {
    const long n = (long)T * 16 * 8;
    for (long i = (long)bid * NTHREADS + tid; i < n; i += (long)GRID * NTHREADS) {
        const long th = i >> 3; const int ch = (int)(i & 7);
        const float l0 = lse[th], l1 = lse[(long)T * 16 + th], l2 = lse[2l * T * 16 + th];
        const float m = fmaxf(l0, fmaxf(l1, l2)); const float e0 = __builtin_amdgcn_exp2f((l0 - m) * LOG2E), e1 = __builtin_amdgcn_exp2f((l1 - m) * LOG2E), e2 = __builtin_amdgcn_exp2f((l2 - m) * LOG2E); const float inv = 1.0f / (e0 + e1 + e2);
        const float w0 = e0 * inv, w1 = e1 * inv, w2 = e2 * inv;
        const size_t off = (size_t)th * 64 + ch * 8;
        const u32x4 a = *(const u32x4*)(Og + off), b2 = *(const u32x4*)(Og + (size_t)T * 1024 + off), c2 = *(const u32x4*)(Og + 2 * (size_t)T * 1024 + off);
        u32x4 r;
#pragma unroll
        for (int j = 0; j < 4; ++j) { const float lo = w0 * bflo(a[j]) + w1 * bflo(b2[j]) + w2 * bflo(c2[j]); const float hi2 = w0 * bfhi(a[j]) + w1 * bfhi(b2[j]) + w2 * bfhi(c2[j]); r[j] = cvt_pk_bf16(lo, hi2); }
        *(u32x4*)(O + off) = r;
    }
}

struct Params {
    const float* x; const float* rel_bias; const float* a_w_in; const float* a_w_o; const float* b_w_in; const float* b_w_o; const float* c_w_in; const float* c_q_norm; const float* c_kv_norm;
    const float* c_w_q_up; const float* c_w_kv_up; const float* c_w_o; const float* ln_g; const float* ln_b; const float* moe_w_router; const float* moe_bias; const float* moe_w_gate; const float* moe_w_up;
    const float* moe_w_down; const float* moe_ws_gate; const float* moe_ws_up; const float* moe_ws_down;
    float* out; char* ws; int lo, hi;
};

typedef const Params __attribute__((address_space(4)))* cparams_t;
#define p (*pq)
__global__ void __launch_bounds__(NTHREADS, 2) fwd(Params p_) {
    extern __shared__ __attribute__((aligned(16))) unsigned char lds_raw[];
    LAS unsigned char* lds = (LAS unsigned char*)lds_raw;
    const int wid_s = __builtin_amdgcn_readfirstlane((int)threadIdx.x >> 6);
    if (threadIdx.x < 4) ((LAS unsigned*)(lds + LDS_BARW))[threadIdx.x] = 0u;
    __syncthreads();
    XcdBarrier bar = xcd_barrier_post((unsigned*)(p_.ws + WS_CTL), (volatile LAS unsigned*)(lds + LDS_BARW), wid_s);
    int ph = 0;
#define RUN (ph >= p_.lo && ph < p_.hi)
#define SEAM() do { const bool _b = (ph >= p_.lo) && (ph + 1 < p_.hi); ++ph; if (_b) xcd_barrier(bar); } while (0)
#define RV cparams_t pq = (cparams_t)__builtin_amdgcn_kernarg_segment_ptr(); asm volatile("" : "+s"(pq)); char* ws = pq->ws; int tid = wid_s * 64 + lane_id(); asm volatile("" : "+v"(tid)); int bid = blockIdx.x; asm volatile("" : "+s"(bid)); const int lane = tid & 63, wid = __builtin_amdgcn_readfirstlane(tid >> 6), gw = bid * 8 + wid; \
    bf16_t* HB = (bf16_t*)(ws + WS_HB); char* WB = ws + WS_WB; char* BIG = ws + WS_BIG; float* Y32 = (float*)(BIG + BIG_Y32); float* tabA = (float*)(ws + WS_TABA); float* tabB = (float*)(ws + WS_TABB); \
    LAS float* ctile = (LAS float*)(lds + LDS_STAGE); LAS unsigned char* blk_e = lds + LDS_BLK; LAS int* nblk_p = (LAS int*)(lds + LDS_NBLK); int* etot = (int*)(ws + WS_CTL + CTL_ETOT); \
    float* logits = (float*)(BIG + M_LOG); int* a_e = (int*)(BIG + M_AE); float* a_g = (float*)(BIG + M_AG); int* a_pos = (int*)(BIG + M_APOS); int* a_slot = (int*)(BIG + M_ASLOT); \
    int* whist = (int*)(BIG + M_WHIST); int* slot_tok = (int*)(BIG + M_STOK); float* slot_w = (float*)(BIG + M_SW); bf16_t* Hh = (bf16_t*)(BIG + M_H); unsigned char* YS = (unsigned char*)(BIG + M_YS); \
    (void)bid; (void)lane; (void)wid; (void)gw; (void)HB; (void)WB; (void)BIG; (void)Y32; (void)tabA; (void)tabB; (void)ctile; (void)blk_e; (void)nblk_p; (void)etot; (void)logits; (void)a_e; (void)a_g; (void)a_pos; (void)a_slot; (void)whist; (void)slot_tok; (void)slot_w; (void)Hh; (void)YS;

#pragma nounroll
    for (int layer = 0; layer < DEPTH; ++layer) {
        const int kind = layer % 3, slot = layer / 3;
        if (RUN) { RV REP(0) {
            if (layer == 0) {
                for (int i = bid * NTHREADS + tid; i < 16 * 2048; i += GRID * NTHREADS) { const int h = i >> 11, d = i & 2047; tabA[i] = p.rel_bias[t5_bucket(d) * 16 + h] * LOG2E; }
                for (int i = bid * NTHREADS + tid; i < 3 * 16 * 132; i += GRID * NTHREADS) { const int g = i / (16 * 132), h = (i / 132) % 16, d = i % 132; const int dil = (g == 0) ? 1 : (g == 1) ? 4 : 16;
                    tabB[i] = (d <= 128) ? p.rel_bias[t5_bucket(d * dil) * 16 + h] * LOG2E : 0.f; }
                for (long i = (long)bid * NTHREADS + tid; i < (long)T * DM / 8; i += (long)GRID * NTHREADS) { const f32x4 a = *(const f32x4*)(p.x + i * 8), b2 = *(const f32x4*)(p.x + i * 8 + 4);
                    u32x4 w; w.x = cvt_pk_bf16(a[0], a[1]); w.y = cvt_pk_bf16(a[2], a[3]); w.z = cvt_pk_bf16(b2[0], b2[1]); w.w = cvt_pk_bf16(b2[2], b2[3]); *(u32x4*)(HB + i * 8) = w; }
            }
            const size_t lw = (size_t)layer * 64 * 262144;
            cvt_run(p.moe_w_gate + lw, (bf16_t*)(WB + WB_GU), 1024, 256, 1024, 256, 64, 262144, 524288, 128, 256, 0, ctile, tid, bid);
            cvt_run(p.moe_w_up + lw, (bf16_t*)(WB + WB_GU), 1024, 256, 1024, 256, 64, 262144, 524288, 128, 256, 128, ctile, tid, bid);
            cvt_run(p.moe_w_down + lw, (bf16_t*)(WB + WB_D), 256, 1024, 256, 1024, 64, 262144, 262144, 1 << 30, 0, 0, ctile, tid, bid);
            cvt_run(p.moe_ws_gate + (size_t)layer * 262144, (bf16_t*)(WB + WB_GU) + (size_t)64 * 524288, 1024, 256, 1024, 256, 1, 0, 0, 128, 256, 0, ctile, tid, bid);
            cvt_run(p.moe_ws_up + (size_t)layer * 262144, (bf16_t*)(WB + WB_GU) + (size_t)64 * 524288, 1024, 256, 1024, 256, 1, 0, 0, 128, 256, 128, ctile, tid, bid);
            cvt_run(p.moe_ws_down + (size_t)layer * 262144, (bf16_t*)(WB + WB_D) + (size_t)64 * 262144, 256, 1024, 256, 1024, 1, 0, 0, 1 << 30, 0, 0, ctile, tid, bid);
            cvt_run(p.moe_w_router + (size_t)layer * 65536, (bf16_t*)(WB + WB_R), 1024, 64, 1024, 256, 1, 0, 0, 1 << 30, 0, 0, ctile, tid, bid);
            if (kind == 0) {
                cvt_run(p.a_w_in + (size_t)slot * 1024 * 2888, (bf16_t*)(WB + WB_MIX), 1024, 2888, 1024, 3072, 1, 0, 0, 1 << 30, 0, 0, ctile, tid, bid);
                cvt_run(p.a_w_o + (size_t)slot * 2048 * 1024, (bf16_t*)(WB + WB_MIX2), 2048, 1024, 2048, 1024, 1, 0, 0, 1 << 30, 0, 0, ctile, tid, bid);
            } else if (kind == 1) {
                cvt_run(p.b_w_in, (bf16_t*)(WB + WB_MIX), 1024, 9216, 1024, 9216, 1, 0, 0, 1 << 30, 0, 0, ctile, tid, bid);
                cvt_run(p.b_w_o, (bf16_t*)(WB + WB_MIX2), 1024, 1024, 1024, 1024, 1, 0, 0, 1 << 30, 0, 0, ctile, tid, bid);
            } else {
                cvt_run(p.c_w_in, (bf16_t*)(WB + WB_MIX), 1024, 416, 1024, 512, 1, 0, 0, 1 << 30, 0, 0, ctile, tid, bid);
                cvt_run(p.c_w_q_up, (bf16_t*)(WB + WB_MIX + 1048576), 256, 1536, 256, 1536, 1, 0, 0, 1 << 30, 0, 0, ctile, tid, bid);
                cvt_run(p.c_w_kv_up, (bf16_t*)(WB + WB_MIX + 2097152), 128, 2048, 256, 2048, 1, 0, 0, 1 << 30, 0, 0, ctile, tid, bid);
                cvt_run(p.c_w_o, (bf16_t*)(WB + WB_MIX2), 1024, 1024, 1024, 1024, 1, 0, 0, 1 << 30, 0, 0, ctile, tid, bid);
            }
        } }
        SEAM();
        const int nrounds = (kind == 1) ? 3 : 1;
#pragma nounroll
        for (int rd = 0; rd < nrounds; ++rd) {
            if (RUN) { RV
                pg8::DenseSched S; pg8::EpiBf16 E;
                if (kind == 0) { S.init(HB, 1024, WB + WB_MIX, 1024, T, 3072, GRID, bid); E.O = (bf16_t*)(BIG + A_P); E.ldc = 3072; }
                else if (kind == 1) { S.init(HB, 1024, WB + WB_MIX + (size_t)rd * 3072 * 1024 * 2, 1024, T, 3072, GRID, bid); E.O = (bf16_t*)(BIG + B_P); E.ldc = 3072; }
                else { S.init(HB, 1024, WB + WB_MIX, 1024, T, 512, GRID, bid); E.O = (bf16_t*)(BIG + C_P); E.ldc = 512; }
                REP(1) pg8::gemm_phase(lds + LDS_STAGE, S, E, 1024, tid);
            }
            SEAM();
            if (kind == 0) {
                if (RUN) { RV REP(3) for (int it = gw; it < T / 4; it += NWAVES_TOTAL) { const int b = it % NBATCH, tq = (SEQ / 4 - 1 - it / NBATCH) * 4; score_wave((const bf16_t*)(BIG + A_P), (float*)(BIG + A_SC), b, tq, lane); } }
                SEAM();
                if (RUN) { RV REP(4) for (int it = gw; it < T; it += NWAVES_TOTAL) { const int b = it % NBATCH, t = SEQ - 1 - it / NBATCH; select_wave((const float*)(BIG + A_SC), (unsigned short*)(BIG + A_IDX), b, t, lane); } }
                SEAM();
                if (RUN) { RV
                    const bf16_t* P = (const bf16_t*)(BIG + A_P); bf16_t* O = (bf16_t*)(BIG + A_O); const unsigned short* IDX = (const unsigned short*)(BIG + A_IDX);
                    LAS char* vl = (LAS char*)(lds + LDS_STAGE) + wid * 9728; LAS float* btab = (LAS float*)(lds + LDS_STAGE + 77824);
                    for (int i = tid; i < 512; i += NTHREADS) btab[i] = p.rel_bias[i] * LOG2E;
                    __syncthreads();
                    const int xcd = bid & 7, wi = (bid >> 3) * 8 + wid;
                    REP(5) for (int k = 0; k < 16; ++k) { const int item = wi + 256 * k; const int b = xcd + 8 * (item >> 11), t = item & 2047; dsa_attn_wave(P, IDX, O, b, t, vl, btab, lane); }
                }
                SEAM();
            } else if (kind == 1) {
                if (RUN) { RV
                    const int dil = (rd == 0) ? 1 : (rd == 1) ? 4 : 16; const int Ld = SEQ / dil; const int nqb = Ld / 32;
                    const bf16_t* P = (const bf16_t*)(BIG + B_P); bf16_t* Og = (bf16_t*)(BIG + B_OG) + (size_t)rd * T * 1024; float* lse = (float*)(BIG + B_LSE) + (size_t)rd * T * 16;
                    LAS char* vl = (LAS char*)(lds + LDS_STAGE) + wid * 10240;
                    REP(6) for (int it = gw; it < NBATCH * 16 * 64; it += NWAVES_TOTAL) { const int b = it / (16 * 64), h = (it / 64) % 16, rq = it % 64, r = rq / nqb, qb = rq % nqb; const int i0 = qb * 32;
                        const long base = ((long)b * SEQ + r) * 3072 + h * 64; const long st = (long)dil * 3072;
                        FnDil f; f.i0 = i0; f.sc = 0.125f * LOG2E; f.tab = tabB + (rd * 16 + h) * 132;
                        int kt0 = (i0 - 128) / 32; kt0 = kt0 < 0 ? 0 : kt0;
                        const long orow = ((long)b * SEQ + r + (long)i0 * dil);
                        attn_wave32<64, 64>(P + base + (long)i0 * st, st, P + base + 1024, st, P + base + 2048, st, kt0, qb + 1, Ld - 1, f, Og + orow * 1024 + h * 64, (long)dil * 1024, lse + orow * 16 + h, (long)dil * 16, vl, lane); }
                }
                SEAM();
            } else {
                if (RUN) { RV REP(11) prepc_phase((const bf16_t*)(BIG + C_P), p.c_q_norm, p.c_kv_norm, (bf16_t*)(BIG + C_AQ), (bf16_t*)(BIG + C_AKV), (bf16_t*)(BIG + C_KF), gw, lane); }
                SEAM();
                if (RUN) { RV
                    { pg8::DenseSched S; pg8::EpiBf16 E; S.init(BIG + C_AQ, 256, WB + WB_MIX + 1048576, 256, T, 1536, GRID, bid); E.O = (bf16_t*)(BIG + C_QF); E.ldc = 1536; REP(1) pg8::gemm_phase(lds + LDS_STAGE, S, E, 256, tid); }
                }
                SEAM();
                if (RUN) { RV
                    { pg8::DenseSched S; pg8::EpiKV E; S.init(BIG + C_AKV, 256, WB + WB_MIX + 2097152, 256, T, 2048, GRID, bid); E.Kf = (bf16_t*)(BIG + C_KF); E.V = (bf16_t*)(BIG + C_V); REP(1) pg8::gemm_phase(lds + LDS_STAGE, S, E, 256, tid); }
                }
                SEAM();
                if (RUN) { RV
                    const bf16_t* Qf = (const bf16_t*)(BIG + C_QF); const bf16_t* Kf = (const bf16_t*)(BIG + C_KF); const bf16_t* V = (const bf16_t*)(BIG + C_V); bf16_t* O = (bf16_t*)(BIG + C_O);
                    LAS char* vl = (LAS char*)(lds + LDS_STAGE) + wid * 10240;
                    REP(7) for (int it = gw; it < NBATCH * 64 * 16; it += NWAVES_TOTAL) { const int qb = 63 - (it / (NBATCH * 16)), rem = it % (NBATCH * 16), b = rem >> 4, h = rem & 15; const int t0 = qb * 32; const long row0 = (long)b * SEQ + t0;
                        FnMLA f; f.t0 = t0; f.sc = 0.10206207261596575f * LOG2E;
                        attn_wave32<96, 64>(Qf + row0 * 1536 + h * 96, 1536, Kf + (long)b * SEQ * 1536 + h * 96, 1536, V + (long)b * SEQ * 1024 + h * 64, 1024, 0, qb + 1, SEQ - 1, f, O + row0 * 1024 + h * 64, 1024, nullptr, 0, vl, lane); }
                }
                SEAM();
            }
        }
        if (kind == 1) { if (RUN) { RV REP(11) combine_phase((const bf16_t*)(BIG + B_OG), (const float*)(BIG + B_LSE), (bf16_t*)(BIG + B_O), tid, bid); } SEAM(); }
        if (RUN) { RV
            pg8::DenseSched S; pg8::EpiResid E; E.Hb = HB; E.Y = Y32;
            if (kind == 0) S.init(BIG + A_O, 2048, WB + WB_MIX2, 2048, T, 1024, GRID, bid);
            else if (kind == 1) S.init(BIG + B_O, 1024, WB + WB_MIX2, 1024, T, 1024, GRID, bid);
            else S.init(BIG + C_O, 1024, WB + WB_MIX2, 1024, T, 1024, GRID, bid);
            REP(2) pg8::gemm_phase(lds + LDS_STAGE, S, E, (kind == 0) ? 2048 : 1024, tid);
        }
        SEAM();
        if (RUN) { RV REP(11) ln1_phase(Y32, p.ln_g + (size_t)(layer * 2) * DM, p.ln_b + (size_t)(layer * 2) * DM, HB, gw, lane); }
        SEAM();
        if (RUN) { RV pg8::DenseSched S; pg8::EpiRouter E; S.init(HB, 1024, WB + WB_R, 1024, T, 256, GRID, bid); E.C = logits; REP(8) pg8::gemm_phase(lds + LDS_STAGE, S, E, 1024, tid); }
        SEAM();
        if (RUN) { RV REP(8) route_phase(logits, p.moe_bias + layer * 64, a_e, a_g, a_pos, whist, gw, lane); }
        SEAM();
        if (RUN) { RV REP(8) assign_phase(whist, a_e, a_g, a_pos, a_slot, slot_tok, slot_w, etot, (LAS int*)(lds + LDS_STAGE), tid, bid); }
        SEAM();
        if (RUN) { RV
            const int nblk_r = build_blk_table(etot, blk_e, nblk_p, tid);
            LAS int* tokw = (LAS int*)(lds + LDS_TOKW);
            pg8::MoeSched<true> S; S.A = (const char*)HB; S.Bt = WB + WB_GU; S.lda = 1024; S.ldbv = 1024; S.b_estride = (size_t)512 * 1024 * 2; S.npn_shift = 1; S.nblk_r = nblk_r; S.G = GRID; S.c = bid; S.tokw = tokw; S.blk_e = blk_e;
            { pg8::Unit u; for (int i = 0; i < 12 && S.next(i, u); ++i) if (tid < 256) { const int sl = u.slot0 + tid; int tok; float w8; if (u.e == 64) { tok = sl - SH_SLOT0; w8 = 1.0f; } else { tok = slot_tok[sl]; w8 = slot_w[sl]; if (tok < 0) { tok = 0; w8 = 0.f; } }
                    tokw[(i * 256 + tid) * 2] = tok; tokw[(i * 256 + tid) * 2 + 1] = __float_as_int(w8 * YS_SCALE); } }
            __syncthreads();
            pg8::EpiSwiglu E; E.H = Hh; E.tokw = tokw;
            REP(9) pg8::gemm_phase(lds + LDS_STAGE, S, E, 1024, tid);
        }
        SEAM();
        if (RUN) { RV
            const int nblk_r = build_blk_table(etot, blk_e, nblk_p, tid);
            pg8::MoeSched<false> S; S.A = (const char*)Hh; S.Bt = WB + WB_D; S.lda = 256; S.ldbv = 256; S.b_estride = (size_t)1024 * 256 * 2; S.npn_shift = 2; S.nblk_r = nblk_r; S.G = GRID; S.c = bid; S.tokw = (LAS int*)(lds + LDS_TOKW); S.blk_e = blk_e;
            pg8::EpiDown E; E.YS = YS;
            REP(10) pg8::gemm_phase(lds + LDS_STAGE, S, E, 256, tid);
        }
        SEAM();
        if (RUN) { RV ln2_phase(YS, a_slot, p.ln_g + (size_t)(layer * 2 + 1) * DM, p.ln_b + (size_t)(layer * 2 + 1) * DM, HB, (layer == DEPTH - 1) ? p.out : nullptr, gw, lane); }
        SEAM();
    }
#undef RUN
#undef SEAM
#undef RV
#undef p
}

static int count_regions() {
    int n = 0;
    for (int layer = 0; layer < DEPTH; ++layer) { const int kind = layer % 3; n += 1; const int nr = (kind == 1) ? 3 : 1; for (int r = 0; r < nr; ++r) n += (kind == 0) ? 4 : (kind == 1) ? 2 : 5; if (kind == 1) n += 1; n += 2; n += 6; }
    return n;
}

extern "C" void kernel_launch(void* const* d_in, const int* in_sizes, int n_in, void* d_out, int out_size, void* d_ws, size_t ws_size, hipStream_t stream) {
    static int ready = 0;
    if (!ready) {
        if (n_in != 22 || out_size != T * DM || ws_size < WS_END) { fprintf(stderr, "kernel_launch: unexpected shapes (n_in %d out %d ws %zu need %zu)\n", n_in, out_size, ws_size, (size_t)WS_END); ready = -1; return; }
        int dev = 0, cus = 0, per_cu = 0;
        if (hipGetDevice(&dev) != hipSuccess || hipDeviceGetAttribute(&cus, hipDeviceAttributeMultiprocessorCount, dev) != hipSuccess) { ready = -1; return; }
        if (hipFuncSetAttribute((const void*)fwd, hipFuncAttributeMaxDynamicSharedMemorySize, LDS_BYTES) != hipSuccess) { fprintf(stderr, "kernel_launch: hipFuncSetAttribute failed\n"); ready = -1; return; }
        if (hipOccupancyMaxActiveBlocksPerMultiprocessor(&per_cu, (const void*)fwd, NTHREADS, LDS_BYTES) != hipSuccess || per_cu < 1) { fprintf(stderr, "kernel_launch: occupancy query says %d\n", per_cu); ready = -1; return; }
        if (cus < GRID) { fprintf(stderr, "kernel_launch: %d CUs < %d\n", cus, GRID); ready = -1; return; }
        ready = 1;
    }
    if (ready < 0) return;
    hipMemsetAsync((char*)d_ws + WS_CTL, 0, CTL_BYTES, stream);
    Params p{};
    const float** pp = (const float**)&p;
    for (int i = 0; i < 22; ++i) pp[i] = (const float*)d_in[i];
    p.out = (float*)d_out; p.ws = (char*)d_ws;
#if MULTI_LAUNCH
    const int nreg = count_regions();
    for (int r = 0; r < nreg; ++r) { p.lo = r; p.hi = r + 1; hipLaunchKernelGGL(fwd, dim3(GRID), dim3(NTHREADS), LDS_BYTES, stream, p); }
#else
    p.lo = 0; p.hi = 1 << 30;
    hipLaunchKernelGGL(fwd, dim3(GRID), dim3(NTHREADS), LDS_BYTES, stream, p);
#endif
}
```

```cpp
#include <hip/hip_runtime.h>
#include <cstdio>
#include <cstdint>

#ifndef DEBUG_CHECKS
#define DEBUG_CHECKS 0
#endif
#ifndef REPEAT_MASK
#define REPEAT_MASK 0
#endif
#define REP(bit) for (int rep_ = 0; rep_ < ((((REPEAT_MASK) >> (bit)) & 1) + 1); ++rep_)
#ifndef MULTI_LAUNCH
#define MULTI_LAUNCH 0
#endif

#define LAS __attribute__((address_space(3)))
typedef unsigned short bf16_t;
typedef short bf16x8 __attribute__((ext_vector_type(8)));
typedef short s16x4 __attribute__((ext_vector_type(4)));
typedef float f32x2 __attribute__((ext_vector_type(2)));
typedef float f32x4 __attribute__((ext_vector_type(4)));
typedef float f32x16 __attribute__((ext_vector_type(16)));
typedef unsigned u32x4 __attribute__((ext_vector_type(4)));
typedef unsigned u32x2 __attribute__((ext_vector_type(2)));

constexpr int T = 32768, DM = 1024, SEQ = 2048, NBATCH = 16, DEPTH = 4;
constexpr float DN_ALPHA = 1.6817928305074292f;
constexpr float LOG2E = 1.4426950408889634f;
constexpr float LN2F = 0.6931471805599453f;
constexpr float NEGF = -1.0e30f;
constexpr int NSLOT_R = 8 * T + 64 * 256, SH_SLOT0 = NSLOT_R, NSLOT = NSLOT_R + T;
constexpr int GRID = 256, NTHREADS = 512, NWAVES_TOTAL = GRID * 8;

constexpr size_t WS_CTL = 0;
constexpr size_t CTL_DIAG = 16384, CTL_ETOT = 32768, CTL_BYTES = 65536;
constexpr size_t WS_TABA = 65536;
constexpr size_t WS_TABB = WS_TABA + 131072;
constexpr size_t WS_HB = 262144;
constexpr size_t WS_WB = WS_HB + (size_t)T * DM * 2;
constexpr size_t WB_GU = 0, WB_D = 68157440, WB_R = 102236160, WB_MIX = 102760448, WB_MIX2 = WB_MIX + 18874368, WB_BYTES = 125829120;
constexpr size_t WS_BIG = WS_WB + WB_BYTES;
constexpr size_t BIG_Y32 = 408944640;
constexpr size_t A_P = 0, A_IDX = 201326592, A_KV = 218103808, A_KI = 234881024, A_O = 243269632, A_SC = 243269632;
constexpr size_t B_P = 0, B_O = 0, B_OG = 201326592, B_LSE = 402653184;
constexpr size_t C_P = 0, C_AQ = 33554432, C_AKV = 50331648, C_QF = 67108864, C_KF = 167772160, C_V = 268435456, C_O = 335544320;
constexpr size_t M_LOG = 0, M_AE = 8388608, M_AG = 9437184, M_APOS = 10485760, M_ASLOT = 11534336, M_WHIST = 12582912, M_STOK = 13107200, M_SW = 14352384, M_H = 16777216, M_YS = 176160768;
constexpr size_t BIG_BYTES = M_YS + (size_t)NSLOT * 1024 * 2;
constexpr float YS_SCALE = 64.0f, YS_INV = 1.0f / 64.0f;
constexpr size_t WS_END = WS_BIG + BIG_BYTES;

constexpr int LDS_STAGE = 0, LDS_BARW = 131072, LDS_BLK = 131072 + 64, LDS_NBLK = 131072 + 64 + 1280, LDS_TOKW = 135168, LDS_BYTES = 135168 + 12 * 2048;

__device__ __forceinline__ bf16_t f2bf(float f) { unsigned u = __float_as_uint(f); u += 0x7FFFu + ((u >> 16) & 1u); return (bf16_t)(u >> 16); }
__device__ __forceinline__ float bf2f(bf16_t b) { return __uint_as_float(((unsigned)b) << 16); }
__device__ __forceinline__ float bflo(unsigned w) { return __uint_as_float(w << 16); }
__device__ __forceinline__ float bfhi(unsigned w) { return __uint_as_float(w & 0xffff0000u); }
typedef __bf16 bf16x2_t __attribute__((ext_vector_type(2)));
__device__ __forceinline__ unsigned cvt_pk_bf16(float lo, float hi) { const f32x2 v = {lo, hi}; const bf16x2_t b = __builtin_convertvector(v, bf16x2_t); return __builtin_bit_cast(unsigned, b); }
__device__ __forceinline__ float swapmax(float v) { auto rr = __builtin_amdgcn_permlane32_swap(__float_as_uint(v), __float_as_uint(v), false, false); return fmaxf(__uint_as_float(rr[0]), __uint_as_float(rr[1])); }
__device__ __forceinline__ float swapadd2(float a, float b) { auto rr = __builtin_amdgcn_permlane32_swap(__float_as_uint(a), __float_as_uint(b), false, false); return __uint_as_float(rr[0]) + __uint_as_float(rr[1]); }
__device__ __forceinline__ int crow(int r, int hi) { return (r & 3) + 8 * (r >> 2) + 4 * hi; }
__device__ __forceinline__ void sincos_small(float x, float& sn, float& cs) {
    const float k = rintf(x * 0.6366197723675814f); const int q = (int)k;
    float r = fmaf(-k, 1.5707962512969971f, x); r = fmaf(-k, 7.549789415861596e-08f, r);
    const float z = r * r;
    const float sp = r + r * z * (-1.6666654611e-1f + z * (8.3321608736e-3f + z * (-1.9515295891e-4f)));
    const float cp = 1.0f - 0.5f * z + z * z * (4.166664568298827e-2f + z * (-1.388731625493765e-3f + z * 2.443315711809948e-5f));
    const float a = (q & 1) ? cp : sp, b = (q & 1) ? sp : cp;
    sn = (q & 2) ? -a : a; cs = ((q + 1) & 2) ? -b : b;
}
__device__ __forceinline__ float rope_inv_freq(int i) { return __builtin_amdgcn_exp2f(-(float)i * (13.287712379549449f / 16.0f)); }

#define XB_TMO      128
#define XB_XCNT(j)  (256  + 64 * (j))
#define XB_XSUB(j)  (1280 + 64 * (j))
#define XB_XGEN(j)  (2304 + 64 * (j))
#define XB_TOP      3328
#define XB_TOPGEN   3392
#define XCD_BAR_WORDS 3456
#define XB_SPIN_CAP (1u << 18)
__device__ __forceinline__ unsigned xb_ld(unsigned* p)              { return __hip_atomic_load(p, __ATOMIC_RELAXED, __HIP_MEMORY_SCOPE_AGENT); }
__device__ __forceinline__ unsigned xb_add(unsigned* p, unsigned v) { return __hip_atomic_fetch_add(p, v, __ATOMIC_RELAXED, __HIP_MEMORY_SCOPE_AGENT); }
__device__ __forceinline__ unsigned xb_xcc_id() { return (unsigned)__builtin_amdgcn_s_getreg((3 << 11) | 20) & 0xFu; }
#define XB_SPIN(cond, bar) do { unsigned _sp = 0; while (cond) { __builtin_amdgcn_s_sleep(1); \
    if ((++_sp & 255u) == 0u) { if (xb_ld(&(bar)[XB_TMO])) break; if (_sp > XB_SPIN_CAP) { atomicAdd(&(bar)[XB_TMO], 1u); break; } } } } while (0)
struct XcdBarrier { unsigned* bar; unsigned x; volatile LAS unsigned* st; int wid; };
__device__ __forceinline__ int lane_id() { return (int)__builtin_amdgcn_mbcnt_hi(~0u, __builtin_amdgcn_mbcnt_lo(~0u, 0u)); }
__device__ __forceinline__ XcdBarrier xcd_barrier_post(unsigned* bar, volatile LAS unsigned* st, int wid) {
    XcdBarrier b; b.bar = bar; b.x = xb_xcc_id(); b.st = st; b.wid = wid;
    if (wid == 0 && lane_id() == 0) (void)xb_add(&bar[XB_XCNT(b.x)], 1u);
    return b;
}
__device__ __forceinline__ void xcd_barrier_complete(unsigned* bar, unsigned x, unsigned& nloc, unsigned& nx) {
    const unsigned G = gridDim.x * gridDim.y * gridDim.z;
    unsigned sum, cnt, mine, sp = 0u;
    for (;;) {
        sum = 0u; cnt = 0u; mine = 0u;
#pragma unroll
        for (unsigned j = 0; j < 16; ++j) { const unsigned c = xb_ld(&bar[XB_XCNT(j)]); sum += c; cnt += (c > 0u) ? 1u : 0u; mine = (j == x) ? c : mine; }
        if (sum == G) break;
        __builtin_amdgcn_s_sleep(1);
        if ((++sp & 255u) == 0u) { if (xb_ld(&bar[XB_TMO])) break; if (sp > XB_SPIN_CAP) { atomicAdd(&bar[XB_TMO], 1u); break; } }
    }
    nloc = mine > 0u ? mine : 1u; nx = cnt > 0u ? cnt : 1u;
}
__device__ __forceinline__ void xcd_barrier(const XcdBarrier& b_) {
    asm volatile("s_waitcnt vmcnt(0)" ::: "memory");
    __syncthreads();
    XcdBarrier b = b_; asm volatile("" : "+s"(b.bar), "+s"(b.x));
    if (b.wid == 0 && lane_id() == 0) {
        unsigned* bar = b.bar;
        __builtin_amdgcn_s_waitcnt(0);
        unsigned nloc = b.st[0], nx = b.st[1];
        if (nloc == 0u) { xcd_barrier_complete(bar, b.x, nloc, nx); b.st[0] = nloc; b.st[1] = nx; }
        const unsigned old = xb_add(&bar[XB_XSUB(b.x)], 1u);
        const unsigned gen = old / nloc;
        if (old + 1u == (gen + 1u) * nloc) {
            __builtin_amdgcn_fence(__ATOMIC_RELEASE, "agent");
            asm volatile("s_waitcnt vmcnt(0)" ::: "memory");
            const unsigned og = xb_add(&bar[XB_TOP], 1u);
            const unsigned tg = og / nx;
            if (og + 1u == (tg + 1u) * nx) xb_add(&bar[XB_TOPGEN], 1u);
            else XB_SPIN(xb_ld(&bar[XB_TOPGEN]) == tg, bar);
            __builtin_amdgcn_fence(__ATOMIC_ACQUIRE, "agent");
            xb_add(&bar[XB_XGEN(b.x)], 1u);
            asm volatile("s_waitcnt vmcnt(0)" ::: "memory");
        } else {
            XB_SPIN(xb_ld(&bar[XB_XGEN(b.x)]) == gen, bar);
            __builtin_amdgcn_fence(__ATOMIC_ACQUIRE, "agent");
            asm volatile("s_waitcnt vmcnt(0)" ::: "memory");
        }
    }
    __syncthreads();
}

namespace pg8 {
constexpr int BM = 256, BK = 64, HALF = 128, HTB = HALF * BK * 2, STAGE_BYTES = 8 * HTB, NXCD = 8, WGM = 8;
__host__ __device__ __forceinline__ int lds_byte(int r, int c) { const int st = (r >> 4) * 2 + (c >> 5), rr = r & 15, cc = c & 31, ob = rr * 64 + cc * 2; return st * 1024 + (ob ^ (((ob >> 9) & 1) << 5)); }
__host__ __device__ __forceinline__ void stage_rc(int b, int& R, int& C) { const int st = b / 1024, sb = b % 1024, swz = sb ^ (((sb >> 9) & 1) << 5); R = (st >> 1) * 16 + swz / 64; C = (st & 1) * 32 + (swz % 64) / 2; }
__host__ __device__ __forceinline__ int perm32(int rho) { const int n = rho >> 4, i = rho & 15; return 8 * (i >> 2) + 4 * n + (i & 3); }

struct Unit { int pm, pn, e, slot0, ui; };

struct DenseSched {
    static constexpr bool UNIT_VOFF = false;
    const char* A; const char* Bt; int lda, ldbv; int nM, nN, nwg, G, c;
    __device__ __forceinline__ void init(const void* A_, int lda_, const void* Bt_, int ldb_, int M, int N, int G_, int c_) { A = (const char*)A_; Bt = (const char*)Bt_; lda = lda_; ldbv = ldb_; nM = M / BM; nN = N / BM; nwg = nM * nN; G = G_; c = c_; }
    __device__ __forceinline__ bool next(int i, Unit& u) const {
        const long L = (long)i * G + c; if (L >= nwg) return false;
        int wgid = (int)L; { const int q = nwg / NXCD, r = nwg % NXCD, xcd = wgid % NXCD, off = wgid / NXCD; wgid = (xcd < r ? xcd * (q + 1) : r * (q + 1) + (xcd - r) * q) + off; }
        const int nig = WGM * nN, gid = wgid / nig, fm = gid * WGM, gsz = (nM - fm) < WGM ? (nM - fm) : WGM;
        u.pm = fm + ((wgid % nig) % gsz); u.pn = (wgid % nig) / gsz; u.e = 0; u.slot0 = 0; u.ui = i; return true;
    }
    __device__ __forceinline__ const char* a_base(const Unit& u) const { return A + (size_t)u.pm * 256 * lda * 2; }
    __device__ __forceinline__ unsigned a_voff(const Unit&, int row, int col) const { return (unsigned)(row * lda + col) * 2u; }
    __device__ __forceinline__ size_t a_hstep() const { return (size_t)128 * lda * 2; }
    __device__ __forceinline__ const char* b_base(const Unit& u) const { return Bt + (size_t)u.pn * 256 * ldbv * 2; }
    __device__ __forceinline__ int ldb() const { return ldbv; }
};

template <bool GATHER> struct MoeSched {
    static constexpr bool UNIT_VOFF = GATHER; static constexpr bool gather = GATHER;
    const char* A; const char* Bt; int lda, ldbv; size_t b_estride; int npn_shift; int nblk_r; int G, c; const LAS int* tokw; const LAS unsigned char* blk_e;
    __device__ __forceinline__ bool next(int i, Unit& u) const {
        const long L = (long)i * G + c; const int blk = (int)(L >> npn_shift); if (blk >= nblk_r + 128) return false;
        u.pn = (int)(L & ((1 << npn_shift) - 1)); u.pm = blk; u.ui = i;
        if (blk < nblk_r) { u.e = blk_e[blk]; u.slot0 = blk * 256; } else { u.e = 64; u.slot0 = SH_SLOT0 + (blk - nblk_r) * 256; }
        return true;
    }
    __device__ __forceinline__ const char* a_base(const Unit& u) const { return gather ? A : A + (size_t)u.slot0 * lda * 2; }
    __device__ __forceinline__ unsigned a_voff(const Unit& u, int row, int col) const {
        if (gather) { const int tok = tokw[(u.ui * 256 + row) * 2]; return (unsigned)(tok * lda + col) * 2u; }
        return (unsigned)(row * lda + col) * 2u;
    }
    __device__ __forceinline__ size_t a_hstep() const { return GATHER ? (size_t)0 : (size_t)128 * lda * 2; }
    __device__ __forceinline__ const char* b_base(const Unit& u) const { return Bt + (size_t)u.e * b_estride + (size_t)u.pn * 256 * ldbv * 2; }
    __device__ __forceinline__ int ldb() const { return ldbv; }
};

struct EpiBf16 {
    static constexpr int PERMK = 1;
    bf16_t* O; int ldc; bf16_t* OA; bf16_t* OB; int pnA, pnB; int dshift;
    __device__ __forceinline__ void operator()(const f32x4 (&acc)[2][2][4][2], const Unit& u, int wr, int wc, int fr, int fq) const {
        const int row0 = u.pm * BM + wr * 64 + fr; const int cl = wc * 32 + 8 * fq;
        bf16_t* base = O + u.pn * BM; int ld = ldc; int nbj = 2;
        if (u.pn == pnA) { base = OA; ld = 256; } else if (u.pn == pnB) { base = OB; ld = 128; nbj = 1; }
#pragma unroll
        for (int ai = 0; ai < 2; ++ai)
#pragma unroll
            for (int m = 0; m < 4; ++m) { int rw = row0 + ai * HALF + m * 16; if (dshift > 0) { const int sq = rw & (SEQ - 1); rw = (rw & ~(SEQ - 1)) | ((sq & ((1 << dshift) - 1)) << (11 - dshift)) | (sq >> dshift); }
                bf16_t* rowp = base + (size_t)rw * ld + cl;
#pragma unroll
                for (int bj = 0; bj < 2; ++bj) if (bj < nbj) { const f32x4 v0 = acc[ai][bj][m][0], v1 = acc[ai][bj][m][1];
                    u32x4 w; w.x = cvt_pk_bf16(v0[0], v0[1]); w.y = cvt_pk_bf16(v0[2], v0[3]); w.z = cvt_pk_bf16(v1[0], v1[1]); w.w = cvt_pk_bf16(v1[2], v1[3]);
                    *(u32x4*)(rowp + bj * HALF) = w; } }
    }
};
struct EpiKV {
    static constexpr int PERMK = 1;
    bf16_t* Kf; bf16_t* V;
    __device__ __forceinline__ void operator()(const f32x4 (&acc)[2][2][4][2], const Unit& u, int wr, int wc, int fr, int fq) const {
        const int row0 = u.pm * BM + wr * 64 + fr; const bool isK = wc < 2;
        bf16_t* Bp = isK ? Kf : V; const int pitch = isK ? 1536 : 1024, hw = isK ? 96 : 64; const int wi = (wc & 1) * 32 + 8 * fq;
#pragma unroll
        for (int ai = 0; ai < 2; ++ai)
#pragma unroll
            for (int m = 0; m < 4; ++m) { bf16_t* rowp = Bp + (size_t)(row0 + ai * HALF + m * 16) * pitch + (u.pn * 2) * hw + wi;
#pragma unroll
                for (int bj = 0; bj < 2; ++bj) { const f32x4 v0 = acc[ai][bj][m][0], v1 = acc[ai][bj][m][1];
                    u32x4 w; w.x = cvt_pk_bf16(v0[0], v0[1]); w.y = cvt_pk_bf16(v0[2], v0[3]); w.z = cvt_pk_bf16(v1[0], v1[1]); w.w = cvt_pk_bf16(v1[2], v1[3]);
                    *(u32x4*)(rowp + bj * hw) = w; } }
    }
};
struct EpiRouter {
    static constexpr int PERMK = 0;
    float* C;
    __device__ __forceinline__ void operator()(const f32x4 (&acc)[2][2][4][2], const Unit& u, int wr, int wc, int fr, int fq) const {
        if (u.pn != 0 || wc >= 2) return;
        const int row0 = u.pm * BM + wr * 64 + fr, col0 = wc * 32 + 4 * fq;
#pragma unroll
        for (int ai = 0; ai < 2; ++ai)
#pragma unroll
            for (int m = 0; m < 4; ++m) { float* rowp = C + (size_t)(row0 + ai * HALF + m * 16) * 64 + col0;
#pragma unroll
                for (int n = 0; n < 2; ++n) *(f32x4*)(rowp + n * 16) = acc[ai][0][m][n]; }
    }
};
struct EpiResid {
    static constexpr int PERMK = 0;
    const bf16_t* Hb; float* Y;
    __device__ __forceinline__ void operator()(const f32x4 (&acc)[2][2][4][2], const Unit& u, int wr, int wc, int fr, int fq) const {
        const int row0 = u.pm * BM + wr * 64 + fr, col0 = u.pn * BM + wc * 32 + 4 * fq;
#pragma unroll
        for (int ai = 0; ai < 2; ++ai)
#pragma unroll
            for (int m = 0; m < 4; ++m) { const size_t off = (size_t)(row0 + ai * HALF + m * 16) * DM + col0;
#pragma unroll
                for (int bj = 0; bj < 2; ++bj)
#pragma unroll
                    for (int n = 0; n < 2; ++n) { const u32x2 hb = *(const u32x2*)(Hb + off + bj * HALF + n * 16); const f32x4 a = acc[ai][bj][m][n];
                        f32x4 o; o[0] = DN_ALPHA * bflo(hb.x) + a[0]; o[1] = DN_ALPHA * bfhi(hb.x) + a[1]; o[2] = DN_ALPHA * bflo(hb.y) + a[2]; o[3] = DN_ALPHA * bfhi(hb.y) + a[3];
                        *(f32x4*)(Y + off + bj * HALF + n * 16) = o; } }
    }
};
__device__ __forceinline__ float silu_mul(float g, float u) { return g * __builtin_amdgcn_rcpf(1.0f + __builtin_amdgcn_exp2f(-g * LOG2E)) * u; }
struct EpiSwiglu {
    static constexpr int PERMK = 1;
    bf16_t* H; const LAS int* tokw;
    __device__ __forceinline__ void operator()(const f32x4 (&acc)[2][2][4][2], const Unit& u, int wr, int wc, int fr, int fq) const {
        const int rl0 = wr * 64 + fr, col0 = u.pn * 128 + wc * 32 + 8 * fq;
#pragma unroll
        for (int ai = 0; ai < 2; ++ai)
#pragma unroll
            for (int m = 0; m < 4; ++m) { const int rl = rl0 + ai * HALF + m * 16; const float w8 = __int_as_float(tokw[(u.ui * 256 + rl) * 2 + 1]); bf16_t* rowp = H + (size_t)(u.slot0 + rl) * 256 + col0;
                const f32x4 g0 = acc[ai][0][m][0], g1 = acc[ai][0][m][1], u0 = acc[ai][1][m][0] * w8, u1 = acc[ai][1][m][1] * w8;
                u32x4 w; w.x = cvt_pk_bf16(silu_mul(g0[0], u0[0]), silu_mul(g0[1], u0[1])); w.y = cvt_pk_bf16(silu_mul(g0[2], u0[2]), silu_mul(g0[3], u0[3]));
                w.z = cvt_pk_bf16(silu_mul(g1[0], u1[0]), silu_mul(g1[1], u1[1])); w.w = cvt_pk_bf16(silu_mul(g1[2], u1[2]), silu_mul(g1[3], u1[3]));
                *(u32x4*)rowp = w; }
    }
};
struct EpiDown {
    static constexpr int PERMK = 2;
    unsigned char* YS;
    __device__ __forceinline__ void operator()(const f32x4 (&acc)[2][2][4][2], const Unit& u, int wr, int wc, int fr, int fq) const {
        unsigned char* rowp = YS + (size_t)(u.slot0 + wr * 64 + fr) * 1024 + (u.pn * BM + wc * 64 + 16 * fq);
#pragma unroll
        for (int ai = 0; ai < 2; ++ai)
#pragma unroll
            for (int m = 0; m < 4; ++m) {
                u32x4 w;
#pragma unroll
                for (int bj = 0; bj < 2; ++bj)
#pragma unroll
                    for (int n = 0; n < 2; ++n) { const f32x4 v = acc[ai][bj][m][n]; int pk = __float_as_int(v[0]); pk = __builtin_amdgcn_cvt_pk_fp8_f32(v[0], v[1], pk, false); pk = __builtin_amdgcn_cvt_pk_fp8_f32(v[2], v[3], pk, true); w[bj * 2 + n] = (unsigned)pk; }
                *(u32x4*)rowp = w;
                rowp += (m == 3) ? (size_t)(HALF - 48) * 1024 : (size_t)16 * 1024; asm volatile("" : "+v"(rowp));
            }
    }
};

template <class Epi, class Sched>
__device__ __forceinline__ void gemm_phase(LAS unsigned char* lds, const Sched& S, const Epi& E, const int K, const int tid_in) {
    int tid_o = tid_in; asm volatile("" : "+v"(tid_o));
    const int tid = tid_o, wid = __builtin_amdgcn_readfirstlane(tid >> 6), lane = tid & 63, wr = wid >> 2, wc = wid & 3, fr = lane & 15, fq = lane >> 4;
    const int nt = K / BK;
    const int ldb = S.ldb();
    unsigned voffB[2];
#pragma unroll
    for (int i = 0; i < 2; ++i) { int R, C; stage_rc(tid * 16 + i * 8192, R, C);
        if (Epi::PERMK == 2) { const int c0 = 64 * (R >> 5) + 16 * ((R >> 2) & 3) + 4 * ((R >> 4) & 1) + (R & 3); voffB[i] = (unsigned)(c0 * ldb + C) * 2u; }
        else { const int Rb = (Epi::PERMK == 1) ? ((R & ~31) + perm32(R & 31)) : R; voffB[i] = (unsigned)(Rb * ldb + C) * 2u; } }
    const size_t kstep = (size_t)(BK * 2);
    const size_t hstepB = (Epi::PERMK == 2) ? (size_t)8 * ldb * 2 : (size_t)HALF * ldb * 2;
#define PG8_VB1 voffB
    const unsigned ldsw = (unsigned)wid * 1024u;
    const int aoff = lds_byte(wr * 64 + fr, fq * 8), boff = lds_byte(wc * 32 + fr, fq * 8);
#define PG8_SA(b, h) (((b) * 2 + (h)) * HTB)
#define PG8_SB(b, h) ((4 + (b) * 2 + (h)) * HTB)
#define PG8_STAGE(bufoff, gbase, voff) do { _Pragma("unroll") for (int _i = 0; _i < 2; ++_i) \
        __builtin_amdgcn_global_load_lds((const unsigned*)((const char*)(gbase) + (voff)[_i]), (LAS unsigned*)(lds + (bufoff) + ldsw + _i * 8192), 16, 0, 0); } while (0)
#define PG8_LDA(dst, b, h) do { _Pragma("unroll") for (int m = 0; m < 4; ++m) _Pragma("unroll") for (int k = 0; k < 2; ++k) dst[m][k] = *(const LAS bf16x8*)(lds + PG8_SA(b, h) + aoff + m * 2048 + k * 1024); } while (0)
#define PG8_LDB(dst, b, h) do { _Pragma("unroll") for (int n = 0; n < 2; ++n) _Pragma("unroll") for (int k = 0; k < 2; ++k) dst[n][k] = *(const LAS bf16x8*)(lds + PG8_SB(b, h) + boff + n * 2048 + k * 1024); } while (0)
#define PG8_MMA(ai, bj, At, Bt) do { __builtin_amdgcn_s_setprio(1); _Pragma("unroll") for (int m = 0; m < 4; ++m) _Pragma("unroll") for (int n = 0; n < 2; ++n) _Pragma("unroll") for (int k = 0; k < 2; ++k) \
        acc[ai][bj][m][n] = __builtin_amdgcn_mfma_f32_16x16x32_bf16(Bt[n][k], At[m][k], acc[ai][bj][m][n], 0, 0, 0); __builtin_amdgcn_s_setprio(0); } while (0)
#define PG8_WAIT_V(n) asm volatile("s_waitcnt vmcnt(" #n ")" ::: "memory")
#define PG8_WAIT_L(n) asm volatile("s_waitcnt lgkmcnt(" #n ")" ::: "memory")
#define PG8_BAR __builtin_amdgcn_s_barrier()
#define PG8_SCHED __builtin_amdgcn_sched_barrier(0)
    Unit cur, nxt; int ui = 0;
    if (!S.next(0, cur)) return;
    f32x4 acc[2][2][4][2];
#pragma unroll
    for (int a = 0; a < 2; ++a)
#pragma unroll
        for (int b = 0; b < 2; ++b)
#pragma unroll
            for (int m = 0; m < 4; ++m)
#pragma unroll
                for (int n = 0; n < 2; ++n) acc[a][b][m][n] = (f32x4){0.f, 0.f, 0.f, 0.f};
    bf16x8 At[4][2], B0[2][2], B1[2][2];
    unsigned vAc0[2], vAc1[2];
#pragma unroll
    for (int i = 0; i < 2; ++i) { int R, C; stage_rc(tid * 16 + i * 8192, R, C); vAc0[i] = S.a_voff(cur, R, C); vAc1[i] = Sched::UNIT_VOFF ? S.a_voff(cur, HALF + R, C) : 0u; }
    const size_t hstepA = Sched::UNIT_VOFF ? (size_t)0 : S.a_hstep();
#define PG8_VA1 (Sched::UNIT_VOFF ? vAc1 : vAc0)
    const char* cA = S.a_base(cur); const char* cB = S.b_base(cur);
    PG8_STAGE(PG8_SB(0, 0), cB, voffB); PG8_STAGE(PG8_SB(0, 1), cB + hstepB, PG8_VB1); PG8_STAGE(PG8_SA(0, 0), cA, vAc0); PG8_STAGE(PG8_SA(0, 1), cA + hstepA, PG8_VA1);
    if (wr == 1) PG8_BAR;
    PG8_WAIT_V(2); PG8_BAR;
    PG8_STAGE(PG8_SB(1, 0), cB + kstep, voffB); PG8_STAGE(PG8_SA(1, 0), cA + kstep, vAc0); PG8_STAGE(PG8_SB(1, 1), cB + hstepB + kstep, PG8_VB1);
    PG8_WAIT_V(6); PG8_BAR;
    for (;;) {
        const bool has_next = S.next(ui + 1, nxt);
        const char* nA = cA; const char* nB = cB;
        if (has_next) { nA = S.a_base(nxt); nB = S.b_base(nxt); }
#pragma unroll 1
        for (int t = 0; t < nt; t += 2) {
            const bool last = (t == nt - 2);
            const char* a1 = cA + (size_t)(t + 1) * kstep;
            const char* a2 = last ? nA : cA + (size_t)(t + 2) * kstep; const char* b2 = last ? nB : cB + (size_t)(t + 2) * kstep;
            const char* a3 = a2 + kstep; const char* b3 = b2 + kstep;
            asm volatile("" : "+s"(a1), "+s"(a2), "+s"(a3), "+s"(b2), "+s"(b3));
            PG8_LDB(B0, 0, 0); PG8_LDB(B1, 0, 1); PG8_SCHED; PG8_LDA(At, 0, 0); PG8_STAGE(PG8_SA(1, 1), a1 + hstepA, PG8_VA1);
            if (Sched::UNIT_VOFF) { if (last && has_next) {
#pragma unroll
                for (int i = 0; i < 2; ++i) { int R, C; stage_rc(tid * 16 + i * 8192, R, C); vAc0[i] = S.a_voff(nxt, R, C); vAc1[i] = S.a_voff(nxt, HALF + R, C); } } }
            PG8_WAIT_V(8); PG8_WAIT_L(0); PG8_BAR; PG8_MMA(0, 0, At, B0); PG8_MMA(0, 1, At, B1); PG8_BAR; PG8_SCHED;
            PG8_LDA(At, 0, 1); PG8_STAGE(PG8_SB(0, 0), b2, voffB); PG8_STAGE(PG8_SB(0, 1), b2 + hstepB, PG8_VB1); PG8_STAGE(PG8_SA(0, 0), a2, vAc0);
            PG8_WAIT_V(8); PG8_WAIT_L(0); PG8_BAR; PG8_MMA(1, 0, At, B0); PG8_MMA(1, 1, At, B1); PG8_BAR; PG8_SCHED;
            PG8_LDB(B0, 1, 0); PG8_LDB(B1, 1, 1); PG8_SCHED; PG8_LDA(At, 1, 0); PG8_STAGE(PG8_SA(0, 1), a2 + hstepA, PG8_VA1);
            PG8_WAIT_V(8); PG8_WAIT_L(0); PG8_BAR; PG8_MMA(0, 0, At, B0); PG8_MMA(0, 1, At, B1); PG8_BAR; PG8_SCHED;
            PG8_LDA(At, 1, 1); PG8_STAGE(PG8_SB(1, 0), b3, voffB); PG8_STAGE(PG8_SB(1, 1), b3 + hstepB, PG8_VB1); PG8_STAGE(PG8_SA(1, 0), a3, vAc0);
            PG8_WAIT_V(8); PG8_WAIT_L(0); PG8_BAR; PG8_MMA(1, 0, At, B0); PG8_MMA(1, 1, At, B1); PG8_BAR; PG8_SCHED;
        }
        if (wr == 0) PG8_BAR;
        E(acc, cur, wr, wc, fr, fq);
        if (!has_next) break;
#pragma unroll
        for (int a = 0; a < 2; ++a)
#pragma unroll
            for (int b = 0; b < 2; ++b)
#pragma unroll
                for (int m = 0; m < 4; ++m)
#pragma unroll
                    for (int n = 0; n < 2; ++n) acc[a][b][m][n] = (f32x4){0.f, 0.f, 0.f, 0.f};
        cur = nxt; cA = nA; cB = nB; ++ui;
        if (wr == 1) PG8_BAR;
    }
    PG8_WAIT_V(0);
    PG8_BAR;
#undef PG8_SA
#undef PG8_VB1
#undef PG8_VA1
#undef PG8_SB
#undef PG8_STAGE
#undef PG8_LDA
#undef PG8_LDB
#undef PG8_MMA
#undef PG8_WAIT_V
#undef PG8_WAIT_L
#undef PG8_BAR
#undef PG8_SCHED
}
}

typedef short v4i16_t __attribute__((ext_vector_type(4)));
__device__ __forceinline__ s16x4 vtr(const LAS char* p) { return __builtin_bit_cast(s16x4, __builtin_amdgcn_ds_read_tr16_b64_v4i16((LAS v4i16_t*)p)); }

template <int DQK, int DV, class F>
__device__ __forceinline__ void attn_wave32(const bf16_t* __restrict__ Qp, long qs, const bf16_t* __restrict__ Kp, long ks, const bf16_t* __restrict__ Vp, long vs,
                                            int kt0, int kt1, int kmax, const F& f, bf16_t* Op, long os, float* lsep, long lses, LAS char* vl, int lane) {
    constexpr int NS = DQK / 16, NC = DV / 32, CH = DV / 8, VP = (DV == 64) ? 192 : 320, NLD = 32 * CH / 64;
    const int r32 = lane & 31, hi = lane >> 5;
    bf16x8 qf[NS];
#pragma unroll
    for (int s = 0; s < NS; ++s) qf[s] = *(const bf16x8*)(Qp + (long)r32 * qs + 16 * s + 8 * hi);
    f.fix_q(qf, r32, hi);
    f32x16 o[NC];
#pragma unroll
    for (int c = 0; c < NC; ++c)
#pragma unroll
        for (int r = 0; r < 16; ++r) o[c][r] = 0.f;
    float m_run = NEGF, l_run = 0.f;
    const int blk = (lane >> 4) & 1, q4 = (lane & 15) >> 2, p4 = lane & 3;
    const LAS char* vrd = vl + (4 * hi + q4) * VP + (16 * blk + 4 * p4) * 2;
    for (int kt = kt0; kt < kt1; ++kt) {
        const int k0 = kt * 32;
        int krow = k0 + r32; krow = krow > kmax ? kmax : krow;
        const bf16_t* kr = Kp + (long)krow * ks + 8 * hi;
        f32x16 acc;
#pragma unroll
        for (int r = 0; r < 16; ++r) acc[r] = 0.f;
#pragma unroll
        for (int s = 0; s < NS; ++s) { const bf16x8 kf = *(const bf16x8*)(kr + 16 * s); acc = __builtin_amdgcn_mfma_f32_32x32x16_bf16(kf, qf[s], acc, 0, 0, 0); }
#pragma unroll
        for (int i = 0; i < NLD; ++i) { const int idx = lane + 64 * i, row = idx / CH, ch = idx % CH; int vrow = k0 + row; vrow = vrow > kmax ? kmax : vrow;
            const u32x4 v = *(const u32x4*)(Vp + (long)vrow * vs + ch * 8); *(LAS u32x4*)(vl + row * VP + ch * 16) = v; }
        const unsigned ctx = f.tile_ctx(kt, r32);
        float s[16]; float mx = NEGF;
#pragma unroll
        for (int r = 0; r < 16; ++r) { s[r] = f.logit(acc[r], k0 + crow(r, hi), r32, ctx); mx = fmaxf(mx, s[r]); }
        mx = swapmax(mx);
        const float m_new = fmaxf(m_run, mx);
        const float alpha = __builtin_amdgcn_exp2f(m_run - m_new);
        float ls = 0.f;
#pragma unroll
        for (int r = 0; r < 16; ++r) { const float pv = (s[r] > -1.0e29f) ? __builtin_amdgcn_exp2f(s[r] - m_new) : 0.f; s[r] = pv; ls += pv; }
        l_run = l_run * alpha + ls; m_run = m_new;
#pragma unroll
        for (int c = 0; c < NC; ++c)
#pragma unroll
            for (int r = 0; r < 16; ++r) o[c][r] *= alpha;
        bf16x8 pb[2];
#pragma unroll
        for (int j = 0; j < 2; ++j) { u32x4 w; w.x = cvt_pk_bf16(s[8 * j + 0], s[8 * j + 1]); w.y = cvt_pk_bf16(s[8 * j + 2], s[8 * j + 3]); w.z = cvt_pk_bf16(s[8 * j + 4], s[8 * j + 5]); w.w = cvt_pk_bf16(s[8 * j + 6], s[8 * j + 7]); pb[j] = __builtin_bit_cast(bf16x8, w); }
#pragma unroll
        for (int c = 0; c < NC; ++c)
#pragma unroll
            for (int j = 0; j < 2; ++j) {
                const s16x4 lo = vtr(vrd + (16 * j) * VP + 64 * c), h4 = vtr(vrd + (16 * j + 8) * VP + 64 * c);
                const bf16x8 vf = (bf16x8){lo[0], lo[1], lo[2], lo[3], h4[0], h4[1], h4[2], h4[3]};
                o[c] = __builtin_amdgcn_mfma_f32_32x32x16_bf16(vf, pb[j], o[c], 0, 0, 0);
            }
    }
    const float l_tot = swapadd2(l_run, l_run);
    const float inv = 1.0f / l_tot;
    bf16_t* orow = Op + (long)r32 * os;
#pragma unroll
    for (int c = 0; c < NC; ++c)
#pragma unroll
        for (int g = 0; g < 4; ++g) { u32x2 w; w.x = cvt_pk_bf16(o[c][4 * g] * inv, o[c][4 * g + 1] * inv); w.y = cvt_pk_bf16(o[c][4 * g + 2] * inv, o[c][4 * g + 3] * inv);
            *(u32x2*)(orow + 32 * c + 8 * g + 4 * hi) = w; }
    if (lsep != nullptr && hi == 0) lsep[(long)r32 * lses] = (m_run + __builtin_amdgcn_logf(l_tot)) * LN2F;
}

template <int DQK, int MODE>
__device__ __forceinline__ void coop_attn_unit(const bf16_t* __restrict__ Qrow0  , long qs, const bf16_t* __restrict__ K0  , long ks, const bf16_t* __restrict__ V0, long vs,
                                               int q0, int kt_lo, int kt_hi, float sc, const LAS float* tab, int segmask, LAS char* lds, int tid, f32x16 (&o)[2], float& m_out, float& l_out) {
    constexpr int NS = DQK / 16, PK = DQK * 2 + 16, PV = 192, CHK = DQK / 8, NKL = (64 * CHK + 511) / 512, BUFB = 64 * PK + 64 * PV;
    const int lane = tid & 63, wid = tid >> 6, r32 = lane & 31, hi = lane >> 5;
    const int t0w = q0 + wid * 32;
    bf16x8 qf[NS];
    {
        const bf16_t* qp = Qrow0 + (long)(wid * 32 + r32) * qs + 8 * hi;
        float qv[NS][8];
#pragma unroll
        for (int s2 = 0; s2 < NS; ++s2) { const u32x4 w = *(const u32x4*)(qp + 16 * s2);
#pragma unroll
            for (int j = 0; j < 4; ++j) { qv[s2][2 * j] = bflo(w[j]); qv[s2][2 * j + 1] = bfhi(w[j]); } }
        if (MODE == 0) { const float pos = (float)(t0w + r32);
#pragma unroll
            for (int j = 0; j < 8; ++j) { const int i = 8 * hi + j; float sn, cs; sincos_small(pos * rope_inv_freq(i), sn, cs);
                const float x1 = qv[NS - 2][j], x2 = qv[NS - 1][j]; qv[NS - 2][j] = x1 * cs - x2 * sn; qv[NS - 1][j] = x1 * sn + x2 * cs; } }
#pragma unroll
        for (int s2 = 0; s2 < NS; ++s2) { u32x4 w;
#pragma unroll
            for (int j = 0; j < 4; ++j) w[j] = cvt_pk_bf16(qv[s2][2 * j] * sc, qv[s2][2 * j + 1] * sc);
            qf[s2] = __builtin_bit_cast(bf16x8, w); }
    }
#pragma unroll
    for (int c = 0; c < 2; ++c)
#pragma unroll
        for (int r = 0; r < 16; ++r) o[c][r] = 0.f;
    float m_run = NEGF, l_run = 0.f;
    const int blk = (lane >> 4) & 1, q4 = (lane & 15) >> 2, p4 = lane & 3;
    const int vrd_off = 64 * PK + (4 * hi + q4) * PV + (16 * blk + 4 * p4) * 2;
    const int qpos = t0w + r32; const int segs = qpos & ~segmask;
    u32x4 kra[NKL], vra, krb[NKL], vrb;
#define CA_LOAD(KR, VR, kt) do { _Pragma("unroll") for (int i_ = 0; i_ < NKL; ++i_) { const int c = tid + 512 * i_; if (NKL * 512 == 64 * CHK || c < 64 * CHK) { const int row = c / CHK, ch = c % CHK; KR[i_] = *(const u32x4*)(K0 + (long)(64 * (kt) + row) * ks + ch * 8); } } \
        { const int row = tid >> 3, ch = tid & 7; VR = *(const u32x4*)(V0 + (long)(64 * (kt) + row) * vs + ch * 8); } } while (0)
#define CA_STORE(KR, VR, buf) do { LAS char* Kt_ = lds + (buf) * BUFB; _Pragma("unroll") for (int i_ = 0; i_ < NKL; ++i_) { const int c = tid + 512 * i_; if (NKL * 512 == 64 * CHK || c < 64 * CHK) { const int row = c / CHK, ch = c % CHK; *(LAS u32x4*)(Kt_ + row * PK + ch * 16) = KR[i_]; } } \
        { const int row = tid >> 3, ch = tid & 7; *(LAS u32x4*)(Kt_ + 64 * PK + row * PV + ch * 16) = VR; } } while (0)
#define CA_COMPUTE(kt, buf) do { const int k0 = 64 * (kt); bool need, full; \
        if (MODE == 0) { need = k0 <= t0w + 31; full = k0 + 63 <= t0w; } else { need = (k0 <= t0w + 31) && (k0 + 63 >= t0w - 128); full = false; } \
        if (need) { const LAS char* Kt = lds + (buf) * BUFB; const LAS char* vrd = Kt + vrd_off; \
            f32x16 p0, p1; _Pragma("unroll") for (int r = 0; r < 16; ++r) { p0[r] = 0.f; p1[r] = 0.f; } \
            _Pragma("unroll") for (int s2 = 0; s2 < NS; ++s2) { const bf16x8 k0f = *(const LAS bf16x8*)(Kt + r32 * PK + (16 * s2 + 8 * hi) * 2), k1f = *(const LAS bf16x8*)(Kt + (32 + r32) * PK + (16 * s2 + 8 * hi) * 2); \
                p0 = __builtin_amdgcn_mfma_f32_32x32x16_bf16(k0f, qf[s2], p0, 0, 0, 0); p1 = __builtin_amdgcn_mfma_f32_32x32x16_bf16(k1f, qf[s2], p1, 0, 0, 0); } \
            float mx = NEGF; \
            if (MODE == 0) { if (!full) { _Pragma("unroll") for (int r = 0; r < 16; ++r) { const int key = k0 + crow(r, hi); p0[r] = (key <= qpos) ? p0[r] : NEGF; p1[r] = (key + 32 <= qpos) ? p1[r] : NEGF; } } } \
            else { _Pragma("unroll") for (int r = 0; r < 16; ++r) { const int key = k0 + crow(r, hi); const int d0 = qpos - key, d1 = d0 - 32; \
                    const bool ok0 = (d0 >= 0) && (d0 <= 128) && (key >= segs), ok1 = (d1 >= 0) && (d1 <= 128) && (key + 32 >= segs); \
                    const float b0 = tab[ok0 ? d0 : 0], b1 = tab[ok1 ? d1 : 0]; p0[r] = ok0 ? p0[r] + b0 : NEGF; p1[r] = ok1 ? p1[r] + b1 : NEGF; } } \
            _Pragma("unroll") for (int r = 0; r < 16; ++r) mx = fmaxf(mx, fmaxf(p0[r], p1[r])); \
            mx = swapmax(mx); \
            if (__any(mx > m_run)) { const float m_new = fmaxf(m_run, mx); const float alpha = __builtin_amdgcn_exp2f(m_run - m_new); l_run *= alpha; m_run = m_new; \
                _Pragma("unroll") for (int c = 0; c < 2; ++c) _Pragma("unroll") for (int r = 0; r < 16; ++r) o[c][r] *= alpha; } \
            float ls = 0.f; \
            _Pragma("unroll") for (int r = 0; r < 16; ++r) { p0[r] = __builtin_amdgcn_exp2f(p0[r] - m_run); p1[r] = __builtin_amdgcn_exp2f(p1[r] - m_run); ls += p0[r] + p1[r]; } \
            l_run += ls; \
            bf16x8 pb[4]; \
            _Pragma("unroll") for (int j = 0; j < 2; ++j) { u32x4 w; w.x = cvt_pk_bf16(p0[8 * j + 0], p0[8 * j + 1]); w.y = cvt_pk_bf16(p0[8 * j + 2], p0[8 * j + 3]); w.z = cvt_pk_bf16(p0[8 * j + 4], p0[8 * j + 5]); w.w = cvt_pk_bf16(p0[8 * j + 6], p0[8 * j + 7]); pb[j] = __builtin_bit_cast(bf16x8, w); \
                u32x4 w1; w1.x = cvt_pk_bf16(p1[8 * j + 0], p1[8 * j + 1]); w1.y = cvt_pk_bf16(p1[8 * j + 2], p1[8 * j + 3]); w1.z = cvt_pk_bf16(p1[8 * j + 4], p1[8 * j + 5]); w1.w = cvt_pk_bf16(p1[8 * j + 6], p1[8 * j + 7]); pb[2 + j] = __builtin_bit_cast(bf16x8, w1); } \
            _Pragma("unroll") for (int c = 0; c < 2; ++c) _Pragma("unroll") for (int hj = 0; hj < 4; ++hj) { \
                    const s16x4 lo = vtr(vrd + (16 * hj) * PV + 64 * c), h4 = vtr(vrd + (16 * hj + 8) * PV + 64 * c); \
                    const bf16x8 vf = (bf16x8){lo[0], lo[1], lo[2], lo[3], h4[0], h4[1], h4[2], h4[3]}; \
                    o[c] = __builtin_amdgcn_mfma_f32_32x32x16_bf16(vf, pb[hj], o[c], 0, 0, 0); } \
        } } while (0)
    const int nt = kt_hi - kt_lo;
    CA_LOAD(kra, vra, kt_lo);
    CA_LOAD(krb, vrb, kt_lo + 1);
    __syncthreads();
    CA_STORE(kra, vra, 0);
    __syncthreads();
    for (int it = 0; it < nt; it += 2) {
        if (it + 2 < nt) CA_LOAD(kra, vra, kt_lo + it + 2);
        CA_COMPUTE(kt_lo + it, 0);
        if (it + 1 < nt) CA_STORE(krb, vrb, 1);
        __syncthreads();
        if (it + 1 < nt) {
            if (it + 3 < nt) CA_LOAD(krb, vrb, kt_lo + it + 3);
            CA_COMPUTE(kt_lo + it + 1, 1);
            if (it + 2 < nt) CA_STORE(kra, vra, 0);
            __syncthreads();
        }
    }
#undef CA_LOAD
#undef CA_STORE
#undef CA_COMPUTE
    m_out = m_run; l_out = swapadd2(l_run, l_run);
}

struct FnMLA {
    int t0; float sc;
    __device__ __forceinline__ void fix_q(bf16x8 (&qf)[6], int r32, int hi) const {
        const float pos = (float)(t0 + r32);
#pragma unroll
        for (int j = 0; j < 8; ++j) { const int i = 8 * hi + j; const float ang = pos * rope_inv_freq(i); float sn, cs; sincos_small(ang, sn, cs);
            const float x1 = bf2f((bf16_t)qf[4][j]), x2 = bf2f((bf16_t)qf[5][j]); qf[4][j] = (short)f2bf(x1 * cs - x2 * sn); qf[5][j] = (short)f2bf(x1 * sn + x2 * cs); }
    }
    __device__ __forceinline__ unsigned tile_ctx(int, int) const { return 0u; }
    __device__ __forceinline__ float logit(float a, int key, int r32, unsigned) const { return (key <= t0 + r32) ? a * sc : NEGF; }
};
struct FnDil {
    int i0; float sc; const float* tab;
    template <int N> __device__ __forceinline__ void fix_q(bf16x8 (&)[N], int, int) const {}
    __device__ __forceinline__ unsigned tile_ctx(int, int) const { return 0u; }
    __device__ __forceinline__ float logit(float a, int key, int r32, unsigned) const { const int d = i0 + r32 - key; const bool ok = (d >= 0) && (d <= 128); const int dc = ok ? d : 0; return ok ? a * sc + tab[dc] : NEGF; }
};
struct FnDsa {
    int t0; float sc; const float* tab; const unsigned* bm;
    template <int N> __device__ __forceinline__ void fix_q(bf16x8 (&)[N], int, int) const {}
    __device__ __forceinline__ unsigned tile_ctx(int kt, int r32) const { return bm[(long)r32 * 64 + kt]; }
    __device__ __forceinline__ float logit(float a, int key, int r32, unsigned ctx) const { const int d = t0 + r32 - key; const bool ok = ((ctx >> (key & 31)) & 1u) != 0u && d >= 0; const int dc = ok ? d : 0; return ok ? a * sc + tab[dc] : NEGF; }
};

__device__ __forceinline__ unsigned halfsum32(unsigned v) { v += __shfl_xor(v, 16); v += __shfl_xor(v, 8); v += __shfl_xor(v, 4); v += __shfl_xor(v, 2); v += __shfl_xor(v, 1); return v; }
__device__ __forceinline__ unsigned ord_u32(float f) { const unsigned u = __float_as_uint(f); return (u & 0x80000000u) ? ~u : (u | 0x80000000u); }
__device__ __forceinline__ void score_wave(const bf16_t* __restrict__ P, const bf16_t* __restrict__ KI, float* __restrict__ scores, int b, int t0, int lane) {
    const int r32 = lane & 31, hi = lane >> 5;
    const long rowb = (long)b * SEQ;
    const bf16_t* qrow = P + (rowb + t0 + (r32 >> 3)) * 3072 + 2304 + (r32 & 7) * 64 + 8 * hi;
    bf16x8 qf[4];
#pragma unroll
    for (int s = 0; s < 4; ++s) qf[s] = *(const bf16x8*)(qrow + 16 * s);
    float w[16];
#pragma unroll
    for (int r = 0; r < 16; ++r) w[r] = bf2f(KI[(rowb + t0 + (r >> 2)) * 128 + 64 + (r & 3) + 4 * hi]) * (0.125f * 0.35355339059327373f);
    const int tA = t0 + 2 * hi, tB = tA + 1;
    const int nkt = (t0 + 3) / 32 + 1;
    float* sAo = scores + (rowb + tA) * SEQ + r32; float* sBo = scores + (rowb + tB) * SEQ + r32;
    for (int kt = 0; kt < nkt; ++kt) {
        const bf16_t* kr = KI + (rowb + kt * 32 + r32) * 128 + 8 * hi;
        f32x16 acc;
#pragma unroll
        for (int r = 0; r < 16; ++r) acc[r] = 0.f;
#pragma unroll
        for (int s = 0; s < 4; ++s) { const bf16x8 kf = *(const bf16x8*)(kr + 16 * s); acc = __builtin_amdgcn_mfma_f32_32x32x16_bf16(qf[s], kf, acc, 0, 0, 0); }
        float p[4];
#pragma unroll
        for (int q = 0; q < 4; ++q) { float a = 0.f;
#pragma unroll
            for (int i = 0; i < 4; ++i) a += w[4 * q + i] * fmaxf(acc[4 * q + i], 0.f);
            p[q] = a; }
        const float sA = swapadd2(p[0], p[2]), sB = swapadd2(p[1], p[3]);
        sAo[kt * 32] = sA; sBo[kt * 32] = sB;
    }
}
__device__ __forceinline__ void select_wave(const float* __restrict__ scores, unsigned short* __restrict__ idxg, int b, int t, int lane) {
    const long row = (long)b * SEQ + t;
    unsigned short* ix = idxg + row * 256;
    if (t < 256) { for (int j = lane; j <= t; j += 64) ix[j] = (unsigned short)j; return; }
    const float* sr = scores + row * SEQ;
    unsigned u[32];
#pragma unroll
    for (int j = 0; j < 32; ++j) { const int key = 64 * j + lane; float v = 0.f; if (64 * j <= t) v = sr[key]; u[j] = (key <= t) ? ord_u32(v) : 0u; }
    unsigned thr = 0u;
    for (int bit = 31; bit >= 0; --bit) {
        const unsigned c = thr | (1u << bit); int n = 0;
#pragma unroll
        for (int j = 0; j < 32; ++j) n += __popcll(__ballot(u[j] >= c));
        thr = (n >= 256) ? c : thr;
    }
    int g = 0;
#pragma unroll
    for (int j = 0; j < 32; ++j) g += __popcll(__ballot(u[j] > thr));
    const int need = 256 - g; int eq = 0, base = 0;
    const unsigned long long lt = (1ull << lane) - 1ull;
#pragma unroll
    for (int j = 0; j < 32; ++j) {
        const bool isEq = (u[j] == thr); const unsigned long long be = __ballot(isEq);
        const bool sel = (u[j] > thr) || (isEq && (eq + __popcll(be & lt) < need));
        eq += __popcll(be);
        const unsigned long long bs = __ballot(sel);
        if (sel) ix[base + __popcll(bs & lt)] = (unsigned short)(64 * j + lane);
        base += __popcll(bs);
    }
}

__device__ __forceinline__ void dsa_attn_wave(const bf16_t* __restrict__ P, const bf16_t* __restrict__ KV, const unsigned short* __restrict__ idxg, bf16_t* __restrict__ O, int b, int t, LAS char* vl, const LAS float* btab, int lane) {
    constexpr int VP = 288;
    const int hd = lane & 15, g = lane >> 4;
    const long rowb = (long)b * SEQ, row = rowb + t;
    const int cnt = (t + 1 < 256) ? (t + 1) : 256;
    LAS unsigned short* ixl = (LAS unsigned short*)(vl + 32 * VP);
    {
        const u32x2 raw = *(const u32x2*)(idxg + row * 256 + 4 * lane);
        u32x2 w; const int j = 4 * lane;
        w.x = ((j < cnt) ? (raw.x & 0xffffu) : 0u) | ((j + 1 < cnt) ? (raw.x & 0xffff0000u) : 0u);
        w.y = ((j + 2 < cnt) ? (raw.y & 0xffffu) : 0u) | ((j + 3 < cnt) ? (raw.y & 0xffff0000u) : 0u);
        *(LAS u32x2*)(ixl + 4 * lane) = w;
    }
    bf16x8 qf[4], qb;
#pragma unroll
    for (int s = 0; s < 4; ++s) qf[s] = *(const bf16x8*)(P + row * 3072 + hd * 128 + 32 * s + 8 * g);
    { u32x4 w;
#pragma unroll
        for (int j = 0; j < 4; ++j) w[j] = cvt_pk_bf16(btab[(8 * g + 2 * j) * 16 + hd] * 7.8421827f, btab[(8 * g + 2 * j + 1) * 16 + hd] * 7.8421827f);
        qb = __builtin_bit_cast(bf16x8, w); }
    const bf16_t* Kb = KV + rowb * 256 + 8 * g; const bf16_t* Vb = KV + rowb * 256 + 128 + (lane & 3) * 8;
    int kid[16];
#pragma unroll
    for (int tau = 0; tau < 16; ++tau) kid[tau] = ixl[16 * tau + hd];
    const int vr = lane >> 2;
    int vk[16];
#pragma unroll
    for (int m = 0; m < 8; ++m) { vk[2 * m] = ixl[32 * m + vr]; vk[2 * m + 1] = ixl[32 * m + 16 + vr]; }
    f32x4 sT[16];
    bf16x8 kfa[8], kfb[8];
#define DSA_LOADK(dst, c) do { _Pragma("unroll") for (int tt = 0; tt < 2; ++tt) { const bf16_t* kr = Kb + (long)kid[2 * (c) + tt] * 256; \
        _Pragma("unroll") for (int s = 0; s < 4; ++s) dst[tt * 4 + s] = *(const bf16x8*)(kr + 32 * s); } } while (0)
#define DSA_MMAK(src, c) do { _Pragma("unroll") for (int tt = 0; tt < 2; ++tt) { f32x4 acc = (f32x4){0.f, 0.f, 0.f, 0.f}; \
        _Pragma("unroll") for (int s = 0; s < 4; ++s) acc = __builtin_amdgcn_mfma_f32_16x16x32_bf16(src[tt * 4 + s], qf[s], acc, 0, 0, 0); \
        { const int dist = t - kid[2 * (c) + tt]; int bk = 16 + (int)((__builtin_amdgcn_logf((float)dist) - 4.0f) * (16.0f / 7.0f)); bk = bk > 31 ? 31 : bk; bk = dist < 16 ? dist : bk; bk = bk < 0 ? 0 : bk; \
          const unsigned one = ((bk >> 3) == g) ? (0x3F80u << (16 * (bk & 1))) : 0u; const int wsel = (bk & 7) >> 1; u32x4 oh; oh.x = wsel == 0 ? one : 0u; oh.y = wsel == 1 ? one : 0u; oh.z = wsel == 2 ? one : 0u; oh.w = wsel == 3 ? one : 0u; \
          acc = __builtin_amdgcn_mfma_f32_16x16x32_bf16(__builtin_bit_cast(bf16x8, oh), qb, acc, 0, 0, 0); } \
        sT[2 * (c) + tt] = acc; } } while (0)
    DSA_LOADK(kfa, 0); DSA_LOADK(kfb, 1);
    DSA_MMAK(kfa, 0); DSA_LOADK(kfa, 2); DSA_MMAK(kfb, 1); DSA_LOADK(kfb, 3); DSA_MMAK(kfa, 2); DSA_LOADK(kfa, 4); DSA_MMAK(kfb, 3); DSA_LOADK(kfb, 5);
    DSA_MMAK(kfa, 4); DSA_LOADK(kfa, 6); DSA_MMAK(kfb, 5); DSA_LOADK(kfb, 7); DSA_MMAK(kfa, 6); DSA_MMAK(kfb, 7);
#undef DSA_LOADK
#undef DSA_MMAK
    u32x4 vv[8];
#define DSA_LOADV(m) do { const bf16_t* v0 = Vb + (long)vk[2 * (m)] * 256; const bf16_t* v1 = Vb + (long)vk[2 * (m) + 1] * 256; \
        _Pragma("unroll") for (int i = 0; i < 8; ++i) vv[i] = *(const u32x4*)(((i & 1) ? v1 : v0) + (i >> 1) * 32); } while (0)
    DSA_LOADV(0);
    const float sc2 = 0.08838834764831845f * LOG2E;
    if (cnt < 256) { const int lim = cnt - 4 * g;
#pragma unroll
        for (int tau = 0; tau < 16; ++tau)
#pragma unroll
            for (int i = 0; i < 4; ++i) sT[tau][i] = (16 * tau + i < lim) ? sT[tau][i] : NEGF; }
    float mx = NEGF;
#pragma unroll
    for (int tau = 0; tau < 16; ++tau) mx = fmaxf(fmaxf(mx, fmaxf(sT[tau][0], sT[tau][1])), fmaxf(sT[tau][2], sT[tau][3]));
    mx = fmaxf(mx, __shfl_xor(mx, 16)); mx = fmaxf(mx, __shfl_xor(mx, 32));
    const float m2 = mx * sc2;
    float ls = 0.f;
#pragma unroll
    for (int tau = 0; tau < 16; ++tau)
#pragma unroll
        for (int i = 0; i < 4; ++i) { const float pv = __builtin_amdgcn_exp2f(fmaf(sT[tau][i], sc2, -m2)); sT[tau][i] = pv; ls += pv; }
    ls += __shfl_xor(ls, 16); ls += __shfl_xor(ls, 32);
    const float inv = 1.0f / ls;
    f32x4 o[8];
#pragma unroll
    for (int c = 0; c < 8; ++c) o[c] = (f32x4){0.f, 0.f, 0.f, 0.f};
    const int q4 = (lane & 15) >> 2, p4 = lane & 3;
    const LAS char* vrd = vl + (4 * g + q4) * VP + 8 * p4;
    LAS char* vwr = vl + vr * VP + (lane & 3) * 16;
#pragma unroll
    for (int m = 0; m < 8; ++m) {
#pragma unroll
        for (int i = 0; i < 8; ++i) *(LAS u32x4*)(vwr + (i & 1) * 16 * VP + (i >> 1) * 64) = vv[i];
        if (m + 1 < 8) DSA_LOADV(m + 1);
        u32x4 w; w.x = cvt_pk_bf16(sT[2 * m][0], sT[2 * m][1]); w.y = cvt_pk_bf16(sT[2 * m][2], sT[2 * m][3]); w.z = cvt_pk_bf16(sT[2 * m + 1][0], sT[2 * m + 1][1]); w.w = cvt_pk_bf16(sT[2 * m + 1][2], sT[2 * m + 1][3]);
        const bf16x8 pb = __builtin_bit_cast(bf16x8, w);
        s16x4 lo[8], h4[8];
#pragma unroll
        for (int c = 0; c < 8; ++c) { lo[c] = vtr(vrd + 32 * c); h4[c] = vtr(vrd + 16 * VP + 32 * c); }
#pragma unroll
        for (int c = 0; c < 8; ++c) {
            const bf16x8 vf = (bf16x8){lo[c][0], lo[c][1], lo[c][2], lo[c][3], h4[c][0], h4[c][1], h4[c][2], h4[c][3]};
            o[c] = __builtin_amdgcn_mfma_f32_16x16x32_bf16(vf, pb, o[c], 0, 0, 0);
        }
    }
#undef DSA_LOADV
    bf16_t* orow = O + row * 2048 + hd * 128 + 4 * g;
#pragma unroll
    for (int c = 0; c < 8; ++c) { u32x2 w; w.x = cvt_pk_bf16(o[c][0] * inv, o[c][1] * inv); w.y = cvt_pk_bf16(o[c][2] * inv, o[c][3] * inv); *(u32x2*)(orow + 16 * c) = w; }
}

__device__ __forceinline__ int t5_bucket(int dist) {
    if (dist < 16) return dist;
    const float df = (float)dist;
    int large = 16 + (int)((__builtin_amdgcn_logf(df) - 4.0f) * (16.0f / 7.0f));
    return large < 31 ? large : 31;
}

__device__ __forceinline__ void cvt_run(const float* __restrict__ src, bf16_t* __restrict__ dst, int K, int N, int Kout, int Nloop, int nb, size_t sbs, size_t dbs, int rchunk, int rstride, int rbase, LAS float* tile, const int tid, const int bid) {
    const int tk = Kout / 64, tn = Nloop / 64, per = tk * tn; const long total = (long)per * nb;
    for (long tix = bid; tix < total; tix += GRID) {
        const int b = (int)(tix / per), r = (int)(tix % per), kt = r % tk, ntile = r / tk, k0 = kt * 64, n0 = ntile * 64;
#pragma unroll
        for (int pass = 0; pass < 2; ++pass) { const int kk = pass * 32 + (tid >> 4), nn = (tid & 15) * 4, k = k0 + kk, n = n0 + nn;
            f32x4 v = (f32x4){0.f, 0.f, 0.f, 0.f}; if (k < K && n < N) v = *(const f32x4*)(src + (size_t)b * sbs + (size_t)k * N + n);
            tile[kk * 65 + nn] = v[0]; tile[kk * 65 + nn + 1] = v[1]; tile[kk * 65 + nn + 2] = v[2]; tile[kk * 65 + nn + 3] = v[3]; }
        __syncthreads();
        { const int nn = tid >> 3, kk8 = (tid & 7) * 8, n = n0 + nn; const int row = rbase + (n / rchunk) * rstride + (n % rchunk);
            u32x4 w; w.x = cvt_pk_bf16(tile[(kk8 + 0) * 65 + nn], tile[(kk8 + 1) * 65 + nn]); w.y = cvt_pk_bf16(tile[(kk8 + 2) * 65 + nn], tile[(kk8 + 3) * 65 + nn]);
            w.z = cvt_pk_bf16(tile[(kk8 + 4) * 65 + nn], tile[(kk8 + 5) * 65 + nn]); w.w = cvt_pk_bf16(tile[(kk8 + 6) * 65 + nn], tile[(kk8 + 7) * 65 + nn]);
            *(u32x4*)(dst + (size_t)b * dbs + (size_t)row * Kout + k0 + kk8) = w; }
        __syncthreads();
    }
}

__device__ __forceinline__ void ln1_phase(const float* __restrict__ Y, const float* __restrict__ g, const float* __restrict__ bta, bf16_t* __restrict__ HB, int gw, int lane) {
    f32x4 gv[4], bv[4];
#pragma unroll
    for (int j = 0; j < 4; ++j) { gv[j] = *(const f32x4*)(g + j * 256 + lane * 4); bv[j] = *(const f32x4*)(bta + j * 256 + lane * 4); }
    for (int row = gw; row < T; row += NWAVES_TOTAL) {
        f32x4 x[4]; float s = 0.f;
#pragma unroll
        for (int j = 0; j < 4; ++j) { x[j] = *(const f32x4*)(Y + (size_t)row * DM + j * 256 + lane * 4); s += (x[j][0] + x[j][1]) + (x[j][2] + x[j][3]); }
#pragma unroll
        for (int o = 32; o >= 1; o >>= 1) s += __shfl_xor(s, o);
        const float mu = s * (1.0f / 1024.0f); float q = 0.f;
#pragma unroll
        for (int j = 0; j < 4; ++j) { x[j] = x[j] - mu; q += (x[j][0] * x[j][0] + x[j][1] * x[j][1]) + (x[j][2] * x[j][2] + x[j][3] * x[j][3]); }
#pragma unroll
        for (int o = 32; o >= 1; o >>= 1) q += __shfl_xor(q, o);
        const float rstd = rsqrtf(q * (1.0f / 1024.0f) + 1e-5f);
#pragma unroll
        for (int j = 0; j < 4; ++j) { const f32x4 y = x[j] * rstd * gv[j] + bv[j]; u32x2 w; w.x = cvt_pk_bf16(y[0], y[1]); w.y = cvt_pk_bf16(y[2], y[3]); *(u32x2*)(HB + (size_t)row * DM + j * 256 + lane * 4) = w; }
    }
}
__device__ __forceinline__ void ln2_phase(const unsigned char* __restrict__ YS, const int* __restrict__ a_slot, const float* __restrict__ g, const float* __restrict__ bta, bf16_t* HB, float* outp, int gw, int lane) {
    f32x4 gv[4], bv[4];
#pragma unroll
    for (int j = 0; j < 4; ++j) { gv[j] = *(const f32x4*)(g + lane * 16 + j * 4); bv[j] = *(const f32x4*)(bta + lane * 16 + j * 4); }
    for (int row = gw; row < T; row += NWAVES_TOTAL) {
        f32x4 x[4], y[4]; float s = 0.f;
        { const u32x4 h0 = *(const u32x4*)(HB + (size_t)row * DM + lane * 16), h1 = *(const u32x4*)(HB + (size_t)row * DM + lane * 16 + 8);
#pragma unroll
            for (int j = 0; j < 2; ++j) { x[j][0] = DN_ALPHA * bflo(h0[2 * j]); x[j][1] = DN_ALPHA * bfhi(h0[2 * j]); x[j][2] = DN_ALPHA * bflo(h0[2 * j + 1]); x[j][3] = DN_ALPHA * bfhi(h0[2 * j + 1]);
                x[2 + j][0] = DN_ALPHA * bflo(h1[2 * j]); x[2 + j][1] = DN_ALPHA * bfhi(h1[2 * j]); x[2 + j][2] = DN_ALPHA * bflo(h1[2 * j + 1]); x[2 + j][3] = DN_ALPHA * bfhi(h1[2 * j + 1]); } }
#pragma unroll
        for (int j = 0; j < 4; ++j) y[j] = (f32x4){0.f, 0.f, 0.f, 0.f};
        int sl[9];
#pragma unroll
        for (int k = 0; k < 8; ++k) sl[k] = a_slot[row * 8 + k];
        sl[8] = SH_SLOT0 + row;
        u32x4 yv[9];
#pragma unroll
        for (int k = 0; k < 9; ++k) yv[k] = *(const u32x4*)(YS + (size_t)sl[k] * 1024 + lane * 16);
#pragma unroll
        for (int k = 0; k < 9; ++k)
#pragma unroll
            for (int j = 0; j < 4; ++j) { const auto lo = __builtin_amdgcn_cvt_pk_f32_fp8((int)yv[k][j], false); const auto hi = __builtin_amdgcn_cvt_pk_f32_fp8((int)yv[k][j], true); y[j][0] += lo[0]; y[j][1] += lo[1]; y[j][2] += hi[0]; y[j][3] += hi[1]; }
#pragma unroll
        for (int j = 0; j < 4; ++j) { x[j] = x[j] + y[j] * YS_INV; s += (x[j][0] + x[j][1]) + (x[j][2] + x[j][3]); }
#pragma unroll
        for (int o = 32; o >= 1; o >>= 1) s += __shfl_xor(s, o);
        const float mu = s * (1.0f / 1024.0f); float q = 0.f;
#pragma unroll
        for (int j = 0; j < 4; ++j) { x[j] = x[j] - mu; q += (x[j][0] * x[j][0] + x[j][1] * x[j][1]) + (x[j][2] * x[j][2] + x[j][3] * x[j][3]); }
#pragma unroll
        for (int o = 32; o >= 1; o >>= 1) q += __shfl_xor(q, o);
        const float rstd = rsqrtf(q * (1.0f / 1024.0f) + 1e-5f);
        f32x4 r[4];
#pragma unroll
        for (int j = 0; j < 4; ++j) r[j] = x[j] * rstd * gv[j] + bv[j];
        if (outp != nullptr) {
#pragma unroll
            for (int j = 0; j < 4; ++j) *(f32x4*)(outp + (size_t)row * DM + lane * 16 + j * 4) = r[j];
        } else { u32x4 w0, w1; w0.x = cvt_pk_bf16(r[0][0], r[0][1]); w0.y = cvt_pk_bf16(r[0][2], r[0][3]); w0.z = cvt_pk_bf16(r[1][0], r[1][1]); w0.w = cvt_pk_bf16(r[1][2], r[1][3]);
            w1.x = cvt_pk_bf16(r[2][0], r[2][1]); w1.y = cvt_pk_bf16(r[2][2], r[2][3]); w1.z = cvt_pk_bf16(r[3][0], r[3][1]); w1.w = cvt_pk_bf16(r[3][2], r[3][3]);
            *(u32x4*)(HB + (size_t)row * DM + lane * 16) = w0; *(u32x4*)(HB + (size_t)row * DM + lane * 16 + 8) = w1; }
    }
}

__device__ __forceinline__ void route_phase(const float* __restrict__ logits, const float* __restrict__ ebias, int* __restrict__ a_e, float* __restrict__ a_g, int* __restrict__ a_pos, int* __restrict__ whist, int gw, int lane) {
    const float eb = ebias[lane];
    int mycnt = 0;
    for (int i = 0; i < 16; ++i) {
        const int t = gw * 16 + i;
        const float lg = logits[(size_t)t * 64 + lane];
        const float sg = 1.0f / (1.0f + __builtin_amdgcn_exp2f(-lg * LOG2E));
        const float c = sg + eb;
        float m1 = c; m1 = fmaxf(m1, __shfl_xor(m1, 1)); m1 = fmaxf(m1, __shfl_xor(m1, 2)); m1 = fmaxf(m1, __shfl_xor(m1, 4));
        int i1 = (c == m1) ? lane : 999; i1 = min(i1, __shfl_xor(i1, 1)); i1 = min(i1, __shfl_xor(i1, 2)); i1 = min(i1, __shfl_xor(i1, 4));
        float m2 = (lane == i1) ? -INFINITY : c; m2 = fmaxf(m2, __shfl_xor(m2, 1)); m2 = fmaxf(m2, __shfl_xor(m2, 2)); m2 = fmaxf(m2, __shfl_xor(m2, 4));
        const float gs = m1 + m2; const int myg = lane >> 3;
        int grank = 0;
#pragma unroll
        for (int g2 = 0; g2 < 8; ++g2) { const float v = __shfl(gs, g2 * 8); grank += (v > gs || (v == gs && g2 < myg)) ? 1 : 0; }
        const float cm = (grank < 4) ? c : -INFINITY;
        int rank = 0;
        for (int l2 = 0; l2 < 64; ++l2) { const float v = __shfl(cm, l2); rank += (v > cm || (v == cm && l2 < lane)) ? 1 : 0; }
        const bool sel = rank < 8;
        float ssum = sel ? sg : 0.f;
#pragma unroll
        for (int o = 32; o >= 1; o >>= 1) ssum += __shfl_xor(ssum, o);
        if (sel) { a_e[t * 8 + rank] = lane; a_g[t * 8 + rank] = sg / ssum * 2.5f; a_pos[t * 8 + rank] = mycnt; mycnt += 1; }
    }
    whist[gw * 64 + lane] = mycnt;
}

__device__ __forceinline__ void assign_phase(const int* __restrict__ whist, const int* __restrict__ a_e, const float* __restrict__ a_g, const int* __restrict__ a_pos, int* __restrict__ a_slot,
                                             int* __restrict__ slot_tok, float* __restrict__ slot_w, int* __restrict__ etot, LAS int* L, const int tid, const int bid) {
    LAS int* red = L; LAS int* red2 = L + 512; LAS int* tot = L + 1024; LAS int* pre = L + 1088; LAS int* pstart = L + 1152; LAS int* base = L + 1216;
    const int e = tid & 63, part = tid >> 6; const int gw0 = bid * 8;
    int s = 0, s2 = 0;
    for (int w = part * 256; w < part * 256 + 256; ++w) { const int v = whist[w * 64 + e]; s += v; s2 += (w < gw0) ? v : 0; }
    red[part * 64 + e] = s; red2[part * 64 + e] = s2;
    __syncthreads();
    if (tid < 64) { int a = 0, b2 = 0;
#pragma unroll
        for (int p2 = 0; p2 < 8; ++p2) { a += red[p2 * 64 + tid]; b2 += red2[p2 * 64 + tid]; }
        tot[tid] = a; pre[tid] = b2;
        const int padded = ((a + 255) >> 8) << 8; int inc = padded;
#pragma unroll
        for (int o = 1; o < 64; o <<= 1) { const int v = __shfl_up(inc, o); if (tid >= o) inc += v; }
        pstart[tid] = inc - padded;
        int run = b2;
        for (int w = 0; w < 8; ++w) { base[w * 64 + tid] = run; run += whist[(gw0 + w) * 64 + tid]; }
        if (bid == 0) etot[tid] = a;
    }
    __syncthreads();
    for (int idx = tid; idx < 1024; idx += NTHREADS) { const int tl = idx >> 3; const int t = bid * 128 + tl; const int ee = a_e[t * 8 + (idx & 7)];
        const int slot = pstart[ee] + base[(tl >> 4) * 64 + ee] + a_pos[t * 8 + (idx & 7)];
        a_slot[t * 8 + (idx & 7)] = slot; slot_tok[slot] = t; slot_w[slot] = a_g[t * 8 + (idx & 7)]; }
    if (bid < 64) { const int ee = bid; const int a = tot[ee], padded = ((a + 255) >> 8) << 8;
        for (int i = a + tid; i < padded; i += NTHREADS) { slot_tok[pstart[ee] + i] = -1; slot_w[pstart[ee] + i] = 0.f; } }
    __syncthreads();
}
__device__ __forceinline__ int build_blk_table(const int* __restrict__ etot, LAS unsigned char* blk_e, LAS int* nblk_p, const int tid) {
    __syncthreads();
    if (tid < 64) { const int nbk = (etot[tid] + 255) >> 8; int inc = nbk;
#pragma unroll
        for (int o = 1; o < 64; o <<= 1) { const int v = __shfl_up(inc, o); if (tid >= o) inc += v; }
        const int st = inc - nbk; for (int i = 0; i < nbk; ++i) blk_e[st + i] = (unsigned char)tid;
        if (tid == 63) *nblk_p = inc; }
    __syncthreads();
    return *nblk_p;
}

__device__ __forceinline__ void prepc_phase(const bf16_t* __restrict__ Pc, const float* __restrict__ qn, const float* __restrict__ kvn, bf16_t* __restrict__ Aq, bf16_t* __restrict__ Akv, bf16_t* __restrict__ Kf, int gw, int lane) {
    const f32x4 gq = *(const f32x4*)(qn + lane * 4); const f32x2 gk = *(const f32x2*)(kvn + lane * 2);
    for (int t = gw; t < T; t += NWAVES_TOTAL) {
        const bf16_t* pr = Pc + (size_t)t * 512;
        const u32x2 cq = *(const u32x2*)(pr + lane * 4); const unsigned ck = *(const unsigned*)(pr + 256 + lane * 2);
        float x0 = bflo(cq.x), x1 = bfhi(cq.x), x2 = bflo(cq.y), x3 = bfhi(cq.y); float sq = x0 * x0 + x1 * x1 + x2 * x2 + x3 * x3;
        float y0 = bflo(ck), y1 = bfhi(ck); float sk = y0 * y0 + y1 * y1;
#pragma unroll
        for (int o = 32; o >= 1; o >>= 1) { sq += __shfl_xor(sq, o); sk += __shfl_xor(sk, o); }
        const float rq = rsqrtf(sq * (1.0f / 256.0f) + 1e-6f), rk = rsqrtf(sk * (1.0f / 128.0f) + 1e-6f);
        u32x2 wq; wq.x = cvt_pk_bf16(x0 * rq * gq[0], x1 * rq * gq[1]); wq.y = cvt_pk_bf16(x2 * rq * gq[2], x3 * rq * gq[3]);
        *(u32x2*)(Aq + (size_t)t * 256 + lane * 4) = wq;
        *(unsigned*)(Akv + (size_t)t * 256 + lane * 2) = cvt_pk_bf16(y0 * rk * gk[0], y1 * rk * gk[1]);
        *(unsigned*)(Akv + (size_t)t * 256 + 128 + lane * 2) = 0u;
        const int h = lane >> 2, qd = lane & 3; const float pos = (float)(t & (SEQ - 1));
        const u32x2 ka = *(const u32x2*)(pr + 384 + 4 * qd), kb = *(const u32x2*)(pr + 400 + 4 * qd);
        const float a[4] = {bflo(ka.x), bfhi(ka.x), bflo(ka.y), bfhi(ka.y)}, bb[4] = {bflo(kb.x), bfhi(kb.x), bflo(kb.y), bfhi(kb.y)};
        float o1[4], o2[4];
#pragma unroll
        for (int j = 0; j < 4; ++j) { const int i = 4 * qd + j; float sn, cs; sincos_small(pos * rope_inv_freq(i), sn, cs); o1[j] = a[j] * cs - bb[j] * sn; o2[j] = a[j] * sn + bb[j] * cs; }
        u32x2 w1, w2; w1.x = cvt_pk_bf16(o1[0], o1[1]); w1.y = cvt_pk_bf16(o1[2], o1[3]); w2.x = cvt_pk_bf16(o2[0], o2[1]); w2.y = cvt_pk_bf16(o2[2], o2[3]);
        *(u32x2*)(Kf + (size_t)t * 1536 + h * 96 + 64 + 4 * qd) = w1; *(u32x2*)(Kf + (size_t)t * 1536 + h * 96 + 80 + 4 * qd) = w2;
    }
}
__device__ __forceinline__ void combine_phase(const bf16_t* __restrict__ Og, const float* __restrict__ lse, bf16_t* __restrict__ O, const int tid, const int bid) {
    const long n = (long)T * 16 * 8;
    for (long i = (long)bid * NTHREADS + tid; i < n; i += (long)GRID * NTHREADS) {
        const long th = i >> 3; const int ch = (int)(i & 7);
        const float l0 = lse[th], l1 = lse[(long)T * 16 + th], l2 = lse[2l * T * 16 + th];
        const float m = fmaxf(l0, fmaxf(l1, l2)); const float e0 = __builtin_amdgcn_exp2f((l0 - m) * LOG2E), e1 = __builtin_amdgcn_exp2f((l1 - m) * LOG2E), e2 = __builtin_amdgcn_exp2f((l2 - m) * LOG2E); const float inv = 1.0f / (e0 + e1 + e2);
        const float w0 = e0 * inv, w1 = e1 * inv, w2 = e2 * inv;
        const size_t off = (size_t)th * 64 + ch * 8;
        const u32x4 a = *(const u32x4*)(Og + off), b2 = *(const u32x4*)(Og + (size_t)T * 1024 + off), c2 = *(const u32x4*)(Og + 2 * (size_t)T * 1024 + off);
        u32x4 r;
#pragma unroll
        for (int j = 0; j < 4; ++j) { const float lo = w0 * bflo(a[j]) + w1 * bflo(b2[j]) + w2 * bflo(c2[j]); const float hi2 = w0 * bfhi(a[j]) + w1 * bfhi(b2[j]) + w2 * bfhi(c2[j]); r[j] = cvt_pk_bf16(lo, hi2); }
        *(u32x4*)(O + off) = r;
    }
}

struct Params {
    const float* x; const float* rel_bias; const float* a_w_in; const float* a_w_o; const float* b_w_in; const float* b_w_o; const float* c_w_in; const float* c_q_norm; const float* c_kv_norm;
    const float* c_w_q_up; const float* c_w_kv_up; const float* c_w_o; const float* ln_g; const float* ln_b; const float* moe_w_router; const float* moe_bias; const float* moe_w_gate; const float* moe_w_up;
    const float* moe_w_down; const float* moe_ws_gate; const float* moe_ws_up; const float* moe_ws_down;
    float* out; char* ws; int lo, hi;
};

typedef const Params __attribute__((address_space(4)))* cparams_t;
#define p (*pq)
__global__ void __launch_bounds__(NTHREADS, 2) fwd(Params p_) {
    extern __shared__ __attribute__((aligned(16))) unsigned char lds_raw[];
    LAS unsigned char* lds = (LAS unsigned char*)lds_raw;
    const int wid_s = __builtin_amdgcn_readfirstlane((int)threadIdx.x >> 6);
    if (threadIdx.x < 4) ((LAS unsigned*)(lds + LDS_BARW))[threadIdx.x] = 0u;
    __syncthreads();
    XcdBarrier bar = xcd_barrier_post((unsigned*)(p_.ws + WS_CTL), (volatile LAS unsigned*)(lds + LDS_BARW), wid_s);
    int ph = 0;
#define RUN (ph >= p_.lo && ph < p_.hi)
#define SEAM() do { const bool _b = (ph >= p_.lo) && (ph + 1 < p_.hi); ++ph; if (_b) xcd_barrier(bar); } while (0)
#define RV cparams_t pq = (cparams_t)__builtin_amdgcn_kernarg_segment_ptr(); asm volatile("" : "+s"(pq)); char* ws = pq->ws; int tid = wid_s * 64 + lane_id(); asm volatile("" : "+v"(tid)); int bid = blockIdx.x; asm volatile("" : "+s"(bid)); const int lane = tid & 63, wid = __builtin_amdgcn_readfirstlane(tid >> 6), gw = bid * 8 + wid; \
    bf16_t* HB = (bf16_t*)(ws + WS_HB); char* WB = ws + WS_WB; char* BIG = ws + WS_BIG; float* Y32 = (float*)(BIG + BIG_Y32); float* tabA = (float*)(ws + WS_TABA); float* tabB = (float*)(ws + WS_TABB); \
    LAS float* ctile = (LAS float*)(lds + LDS_STAGE); LAS unsigned char* blk_e = lds + LDS_BLK; LAS int* nblk_p = (LAS int*)(lds + LDS_NBLK); int* etot = (int*)(ws + WS_CTL + CTL_ETOT); \
    float* logits = (float*)(BIG + M_LOG); int* a_e = (int*)(BIG + M_AE); float* a_g = (float*)(BIG + M_AG); int* a_pos = (int*)(BIG + M_APOS); int* a_slot = (int*)(BIG + M_ASLOT); \
    int* whist = (int*)(BIG + M_WHIST); int* slot_tok = (int*)(BIG + M_STOK); float* slot_w = (float*)(BIG + M_SW); bf16_t* Hh = (bf16_t*)(BIG + M_H); unsigned char* YS = (unsigned char*)(BIG + M_YS); \
    (void)bid; (void)lane; (void)wid; (void)gw; (void)HB; (void)WB; (void)BIG; (void)Y32; (void)tabA; (void)tabB; (void)ctile; (void)blk_e; (void)nblk_p; (void)etot; (void)logits; (void)a_e; (void)a_g; (void)a_pos; (void)a_slot; (void)whist; (void)slot_tok; (void)slot_w; (void)Hh; (void)YS;

#pragma nounroll
    for (int layer = 0; layer < DEPTH; ++layer) {
        const int kind = layer % 3, slot = layer / 3;
        if (RUN) { RV REP(0) {
            if (layer == 0) {
                for (int i = bid * NTHREADS + tid; i < 16 * 2048; i += GRID * NTHREADS) { const int h = i >> 11, d = i & 2047; tabA[i] = p.rel_bias[t5_bucket(d) * 16 + h] * LOG2E; }
                for (int i = bid * NTHREADS + tid; i < 3 * 16 * 132; i += GRID * NTHREADS) { const int g = i / (16 * 132), h = (i / 132) % 16, d = i % 132; const int dil = (g == 0) ? 1 : (g == 1) ? 4 : 16;
                    tabB[i] = (d <= 128) ? p.rel_bias[t5_bucket(d * dil) * 16 + h] * LOG2E : 0.f; }
                for (long i = (long)bid * NTHREADS + tid; i < (long)T * DM / 8; i += (long)GRID * NTHREADS) { const f32x4 a = *(const f32x4*)(p.x + i * 8), b2 = *(const f32x4*)(p.x + i * 8 + 4);
                    u32x4 w; w.x = cvt_pk_bf16(a[0], a[1]); w.y = cvt_pk_bf16(a[2], a[3]); w.z = cvt_pk_bf16(b2[0], b2[1]); w.w = cvt_pk_bf16(b2[2], b2[3]); *(u32x4*)(HB + i * 8) = w; }
            }
            const size_t lw = (size_t)layer * 64 * 262144;
            cvt_run(p.moe_w_gate + lw, (bf16_t*)(WB + WB_GU), 1024, 256, 1024, 256, 64, 262144, 524288, 128, 256, 0, ctile, tid, bid);
            cvt_run(p.moe_w_up + lw, (bf16_t*)(WB + WB_GU), 1024, 256, 1024, 256, 64, 262144, 524288, 128, 256, 128, ctile, tid, bid);
            cvt_run(p.moe_w_down + lw, (bf16_t*)(WB + WB_D), 256, 1024, 256, 1024, 64, 262144, 262144, 1 << 30, 0, 0, ctile, tid, bid);
            cvt_run(p.moe_ws_gate + (size_t)layer * 262144, (bf16_t*)(WB + WB_GU) + (size_t)64 * 524288, 1024, 256, 1024, 256, 1, 0, 0, 128, 256, 0, ctile, tid, bid);
            cvt_run(p.moe_ws_up + (size_t)layer * 262144, (bf16_t*)(WB + WB_GU) + (size_t)64 * 524288, 1024, 256, 1024, 256, 1, 0, 0, 128, 256, 128, ctile, tid, bid);
            cvt_run(p.moe_ws_down + (size_t)layer * 262144, (bf16_t*)(WB + WB_D) + (size_t)64 * 262144, 256, 1024, 256, 1024, 1, 0, 0, 1 << 30, 0, 0, ctile, tid, bid);
            cvt_run(p.moe_w_router + (size_t)layer * 65536, (bf16_t*)(WB + WB_R), 1024, 64, 1024, 256, 1, 0, 0, 1 << 30, 0, 0, ctile, tid, bid);
            if (kind == 0) {
                cvt_run(p.a_w_in + (size_t)slot * 1024 * 2888, (bf16_t*)(WB + WB_MIX), 1024, 2888, 1024, 3072, 1, 0, 0, 1 << 30, 0, 0, ctile, tid, bid);
                cvt_run(p.a_w_o + (size_t)slot * 2048 * 1024, (bf16_t*)(WB + WB_MIX2), 2048, 1024, 2048, 1024, 1, 0, 0, 1 << 30, 0, 0, ctile, tid, bid);
            } else if (kind == 1) {
                cvt_run(p.b_w_in, (bf16_t*)(WB + WB_MIX), 1024, 9216, 1024, 9216, 1, 0, 0, 1 << 30, 0, 0, ctile, tid, bid);
                cvt_run(p.b_w_o, (bf16_t*)(WB + WB_MIX2), 1024, 1024, 1024, 1024, 1, 0, 0, 1 << 30, 0, 0, ctile, tid, bid);
            } else {
                cvt_run(p.c_w_in, (bf16_t*)(WB + WB_MIX), 1024, 416, 1024, 512, 1, 0, 0, 1 << 30, 0, 0, ctile, tid, bid);
                cvt_run(p.c_w_q_up, (bf16_t*)(WB + WB_MIX + 1048576), 256, 1536, 256, 1536, 1, 0, 0, 1 << 30, 0, 0, ctile, tid, bid);
                cvt_run(p.c_w_kv_up, (bf16_t*)(WB + WB_MIX + 2097152), 128, 2048, 256, 2048, 1, 0, 0, 1 << 30, 0, 0, ctile, tid, bid);
                cvt_run(p.c_w_o, (bf16_t*)(WB + WB_MIX2), 1024, 1024, 1024, 1024, 1, 0, 0, 1 << 30, 0, 0, ctile, tid, bid);
            }
        } }
        SEAM();
        const int nrounds = (kind == 1) ? 3 : 1;
#pragma nounroll
        for (int rd = 0; rd < nrounds; ++rd) {
            if (RUN) { RV
                pg8::DenseSched S; pg8::EpiBf16 E;
                if (kind == 0) { S.init(HB, 1024, WB + WB_MIX, 1024, T, 3072, GRID, bid); E.O = (bf16_t*)(BIG + A_P); E.ldc = 3072; E.OA = (bf16_t*)(BIG + A_KV); E.OB = (bf16_t*)(BIG + A_KI); E.pnA = 8; E.pnB = 11; E.dshift = 0; }
                else if (kind == 1) { S.init(HB, 1024, WB + WB_MIX + (size_t)rd * 3072 * 1024 * 2, 1024, T, 3072, GRID, bid); E.O = (bf16_t*)(BIG + B_P); E.ldc = 3072; E.OA = nullptr; E.OB = nullptr; E.pnA = -1; E.pnB = -1; E.dshift = 2 * rd; }
                else { S.init(HB, 1024, WB + WB_MIX, 1024, T, 512, GRID, bid); E.O = (bf16_t*)(BIG + C_P); E.ldc = 512; E.OA = nullptr; E.OB = nullptr; E.pnA = -1; E.pnB = -1; E.dshift = 0; }
                REP(1) pg8::gemm_phase(lds + LDS_STAGE, S, E, 1024, tid);
            }
            SEAM();
            if (kind == 0) {
                if (RUN) { RV REP(3) for (int it = gw; it < T / 4; it += NWAVES_TOTAL) { const int b = it % NBATCH, tq = (SEQ / 4 - 1 - it / NBATCH) * 4; score_wave((const bf16_t*)(BIG + A_P), (const bf16_t*)(BIG + A_KI), (float*)(BIG + A_SC), b, tq, lane); } }
                SEAM();
                if (RUN) { RV REP(4) for (int it = gw; it < T; it += NWAVES_TOTAL) { const int b = it % NBATCH, t = SEQ - 1 - it / NBATCH; select_wave((const float*)(BIG + A_SC), (unsigned short*)(BIG + A_IDX), b, t, lane); } }
                SEAM();
                if (RUN) { RV
                    const bf16_t* P = (const bf16_t*)(BIG + A_P); bf16_t* O = (bf16_t*)(BIG + A_O); const unsigned short* IDX = (const unsigned short*)(BIG + A_IDX);
                    LAS char* vl = (LAS char*)(lds + LDS_STAGE) + wid * 9728; LAS float* btab = (LAS float*)(lds + LDS_STAGE + 77824);
                    for (int i = tid; i < 512; i += NTHREADS) btab[i] = p.rel_bias[i] * LOG2E;
                    __syncthreads();
                    REP(5) for (int k = 0; k < 16; ++k) { const int b = k, t = gw; dsa_attn_wave(P, (const bf16_t*)(BIG + A_KV), IDX, O, b, t, vl, btab, lane); }
                }
                SEAM();
            } else if (kind == 1) {
                if (RUN) { RV
                    const int dsh = 2 * rd, Ld = SEQ >> dsh;
                    const bf16_t* P = (const bf16_t*)(BIG + B_P); bf16_t* Og = (bf16_t*)(BIG + B_OG) + (size_t)rd * T * 1024; float* lse = (float*)(BIG + B_LSE) + (size_t)rd * T * 16;
                    LAS float* tabl = (LAS float*)(lds + LDS_STAGE + 65536);
                    const int lane5 = lane & 31, hi5 = lane >> 5;
                    REP(6) for (int bh = bid; bh < NBATCH * 16; bh += GRID) { const int b = bh >> 4, h = bh & 15;
                        __syncthreads();
                        if (tid < 132) tabl[tid] = tabB[(rd * 16 + h) * 132 + tid];
                        const bf16_t* Pb = P + (long)b * SEQ * 3072 + h * 64;
                        for (int ub = 0; ub < 8; ++ub) { const int q0 = 256 * ub; int ktl = 4 * ub - 2; ktl = ktl < 0 ? 0 : ktl;
                            f32x16 o[2]; float m_run, l_tot;
                            coop_attn_unit<64, 1>(Pb + (long)q0 * 3072, 3072, Pb + 1024, 3072, Pb + 2048, 3072, q0, ktl, 4 * ub + 4, 0.125f * LOG2E, tabl, Ld - 1, (LAS char*)(lds + LDS_STAGE), tid, o, m_run, l_tot);
                            const int u = q0 + wid * 32 + lane5; const int sq = ((u & (Ld - 1)) << dsh) | (u >> (11 - dsh)); const long orow = (long)b * SEQ + sq; const float inv = 1.0f / l_tot;
                            bf16_t* op = Og + orow * 1024 + h * 64;
#pragma unroll
                            for (int c = 0; c < 2; ++c)
#pragma unroll
                                for (int g4 = 0; g4 < 4; ++g4) { u32x2 w; w.x = cvt_pk_bf16(o[c][4 * g4] * inv, o[c][4 * g4 + 1] * inv); w.y = cvt_pk_bf16(o[c][4 * g4 + 2] * inv, o[c][4 * g4 + 3] * inv); *(u32x2*)(op + 32 * c + 8 * g4 + 4 * hi5) = w; }
                            if (hi5 == 0) lse[orow * 16 + h] = (m_run + __builtin_amdgcn_logf(l_tot)) * LN2F;
                        } }
                }
                SEAM();
            } else {
                if (RUN) { RV REP(11) prepc_phase((const bf16_t*)(BIG + C_P), p.c_q_norm, p.c_kv_norm, (bf16_t*)(BIG + C_AQ), (bf16_t*)(BIG + C_AKV), (bf16_t*)(BIG + C_KF), gw, lane); }
                SEAM();
                if (RUN) { RV
                    { pg8::DenseSched S; pg8::EpiBf16 E; S.init(BIG + C_AQ, 256, WB + WB_MIX + 1048576, 256, T, 1536, GRID, bid); E.O = (bf16_t*)(BIG + C_QF); E.ldc = 1536; E.OA = nullptr; E.OB = nullptr; E.pnA = -1; E.pnB = -1; E.dshift = 0; REP(1) pg8::gemm_phase(lds + LDS_STAGE, S, E, 256, tid); }
                }
                SEAM();
                if (RUN) { RV
                    { pg8::DenseSched S; pg8::EpiKV E; S.init(BIG + C_AKV, 256, WB + WB_MIX + 2097152, 256, T, 2048, GRID, bid); E.Kf = (bf16_t*)(BIG + C_KF); E.V = (bf16_t*)(BIG + C_V); REP(1) pg8::gemm_phase(lds + LDS_STAGE, S, E, 256, tid); }
                }
                SEAM();
                if (RUN) { RV
                    const bf16_t* Qf = (const bf16_t*)(BIG + C_QF); const bf16_t* Kf = (const bf16_t*)(BIG + C_KF); const bf16_t* V = (const bf16_t*)(BIG + C_V); bf16_t* O = (bf16_t*)(BIG + C_O);
                    const int lane5 = lane & 31, hi5 = lane >> 5;
                    REP(7) for (int bh = bid; bh < NBATCH * 16; bh += GRID) { const int b = bh >> 4, h = bh & 15; const long rowb = (long)b * SEQ;
                        for (int qi = 0; qi < 8; ++qi) { const int qb = 7 - qi; const int q0 = 256 * qb;
                            f32x16 o[2]; float m_run, l_tot;
                            coop_attn_unit<96, 0>(Qf + (rowb + q0) * 1536 + h * 96, 1536, Kf + rowb * 1536 + h * 96, 1536, V + rowb * 1024 + h * 64, 1024, q0, 0, 4 * qb + 4, 0.10206207261596575f * LOG2E, nullptr, 0, (LAS char*)(lds + LDS_STAGE), tid, o, m_run, l_tot);
                            const float inv = 1.0f / l_tot; bf16_t* op = O + (rowb + q0 + wid * 32 + lane5) * 1024 + h * 64;
#pragma unroll
                            for (int c = 0; c < 2; ++c)
#pragma unroll
                                for (int g4 = 0; g4 < 4; ++g4) { u32x2 w; w.x = cvt_pk_bf16(o[c][4 * g4] * inv, o[c][4 * g4 + 1] * inv); w.y = cvt_pk_bf16(o[c][4 * g4 + 2] * inv, o[c][4 * g4 + 3] * inv); *(u32x2*)(op + 32 * c + 8 * g4 + 4 * hi5) = w; }
                        } }
                }
                SEAM();
            }
        }
        if (kind == 1) { if (RUN) { RV REP(11) combine_phase((const bf16_t*)(BIG + B_OG), (const float*)(BIG + B_LSE), (bf16_t*)(BIG + B_O), tid, bid); } SEAM(); }
        if (RUN) { RV
            pg8::DenseSched S; pg8::EpiResid E; E.Hb = HB; E.Y = Y32;
            if (kind == 0) S.init(BIG + A_O, 2048, WB + WB_MIX2, 2048, T, 1024, GRID, bid);
            else if (kind == 1) S.init(BIG + B_O, 1024, WB + WB_MIX2, 1024, T, 1024, GRID, bid);
            else S.init(BIG + C_O, 1024, WB + WB_MIX2, 1024, T, 1024, GRID, bid);
            REP(2) pg8::gemm_phase(lds + LDS_STAGE, S, E, (kind == 0) ? 2048 : 1024, tid);
        }
        SEAM();
        if (RUN) { RV REP(11) ln1_phase(Y32, p.ln_g + (size_t)(layer * 2) * DM, p.ln_b + (size_t)(layer * 2) * DM, HB, gw, lane); }
        SEAM();
        if (RUN) { RV pg8::DenseSched S; pg8::EpiRouter E; S.init(HB, 1024, WB + WB_R, 1024, T, 256, GRID, bid); E.C = logits; REP(8) pg8::gemm_phase(lds + LDS_STAGE, S, E, 1024, tid); }
        SEAM();
        if (RUN) { RV REP(8) route_phase(logits, p.moe_bias + layer * 64, a_e, a_g, a_pos, whist, gw, lane); }
        SEAM();
        if (RUN) { RV REP(8) assign_phase(whist, a_e, a_g, a_pos, a_slot, slot_tok, slot_w, etot, (LAS int*)(lds + LDS_STAGE), tid, bid); }
        SEAM();
        if (RUN) { RV
            const int nblk_r = build_blk_table(etot, blk_e, nblk_p, tid);
            LAS int* tokw = (LAS int*)(lds + LDS_TOKW);
            pg8::MoeSched<true> S; S.A = (const char*)HB; S.Bt = WB + WB_GU; S.lda = 1024; S.ldbv = 1024; S.b_estride = (size_t)512 * 1024 * 2; S.npn_shift = 1; S.nblk_r = nblk_r; S.G = GRID; S.c = bid; S.tokw = tokw; S.blk_e = blk_e;
            { pg8::Unit u; for (int i = 0; i < 12 && S.next(i, u); ++i) if (tid < 256) { const int sl = u.slot0 + tid; int tok; float w8; if (u.e == 64) { tok = sl - SH_SLOT0; w8 = 1.0f; } else { tok = slot_tok[sl]; w8 = slot_w[sl]; if (tok < 0) { tok = 0; w8 = 0.f; } }
                    tokw[(i * 256 + tid) * 2] = tok; tokw[(i * 256 + tid) * 2 + 1] = __float_as_int(w8 * YS_SCALE); } }
            __syncthreads();
            pg8::EpiSwiglu E; E.H = Hh; E.tokw = tokw;
            REP(9) pg8::gemm_phase(lds + LDS_STAGE, S, E, 1024, tid);
        }
        SEAM();
        if (RUN) { RV
            const int nblk_r = build_blk_table(etot, blk_e, nblk_p, tid);
            pg8::MoeSched<false> S; S.A = (const char*)Hh; S.Bt = WB + WB_D; S.lda = 256; S.ldbv = 256; S.b_estride = (size_t)1024 * 256 * 2; S.npn_shift = 2; S.nblk_r = nblk_r; S.G = GRID; S.c = bid; S.tokw = (LAS int*)(lds + LDS_TOKW); S.blk_e = blk_e;
            pg8::EpiDown E; E.YS = YS;
            REP(10) pg8::gemm_phase(lds + LDS_STAGE, S, E, 256, tid);
        }
        SEAM();
        if (RUN) { RV ln2_phase(YS, a_slot, p.ln_g + (size_t)(layer * 2 + 1) * DM, p.ln_b + (size_t)(layer * 2 + 1) * DM, HB, (layer == DEPTH - 1) ? p.out : nullptr, gw, lane); }
        SEAM();
    }
#undef RUN
#undef SEAM
#undef RV
#undef p
}

static int count_regions() {
    int n = 0;
    for (int layer = 0; layer < DEPTH; ++layer) { const int kind = layer % 3; n += 1; const int nr = (kind == 1) ? 3 : 1; for (int r = 0; r < nr; ++r) n += (kind == 0) ? 4 : (kind == 1) ? 2 : 5; if (kind == 1) n += 1; n += 2; n += 6; }
    return n;
}

extern "C" void kernel_launch(void* const* d_in, const int* in_sizes, int n_in, void* d_out, int out_size, void* d_ws, size_t ws_size, hipStream_t stream) {
    static int ready = 0;
    if (!ready) {
        if (n_in != 22 || out_size != T * DM || ws_size < WS_END) { fprintf(stderr, "kernel_launch: unexpected shapes (n_in %d out %d ws %zu need %zu)\n", n_in, out_size, ws_size, (size_t)WS_END); ready = -1; return; }
        int dev = 0, cus = 0, per_cu = 0;
        if (hipGetDevice(&dev) != hipSuccess || hipDeviceGetAttribute(&cus, hipDeviceAttributeMultiprocessorCount, dev) != hipSuccess) { ready = -1; return; }
        if (hipFuncSetAttribute((const void*)fwd, hipFuncAttributeMaxDynamicSharedMemorySize, LDS_BYTES) != hipSuccess) { fprintf(stderr, "kernel_launch: hipFuncSetAttribute failed\n"); ready = -1; return; }
        if (hipOccupancyMaxActiveBlocksPerMultiprocessor(&per_cu, (const void*)fwd, NTHREADS, LDS_BYTES) != hipSuccess || per_cu < 1) { fprintf(stderr, "kernel_launch: occupancy query says %d\n", per_cu); ready = -1; return; }
        if (cus < GRID) { fprintf(stderr, "kernel_launch: %d CUs < %d\n", cus, GRID); ready = -1; return; }
        ready = 1;
    }
    if (ready < 0) return;
    hipMemsetAsync((char*)d_ws + WS_CTL, 0, CTL_BYTES, stream);
    Params p{};
    const float** pp = (const float**)&p;
    for (int i = 0; i < 22; ++i) pp[i] = (const float*)d_in[i];
    p.out = (float*)d_out; p.ws = (char*)d_ws;
#if MULTI_LAUNCH
    const int nreg = count_regions();
    for (int r = 0; r < nreg; ++r) { p.lo = r; p.hi = r + 1; hipLaunchKernelGGL(fwd, dim3(GRID), dim3(NTHREADS), LDS_BYTES, stream, p); }
#else
    p.lo = 0; p.hi = 1 << 30;
    hipLaunchKernelGGL(fwd, dim3(GRID), dim3(NTHREADS), LDS_BYTES, stream, p);
#endif
}
```
